# Optimizing an MI355X kernel written in HIP

```python
import jax, jax.numpy as jnp
from jax import lax
import numpy as np

D_MODEL = 1024
BATCH = 8
SEQ = 4096
DEPTH = 4

N_MIXERS = 2
N_MLSTM = (DEPTH + 1) // 2
N_HGRN = DEPTH // 2
CHUNK = 64
M_HEADS = 8
M_DV = D_MODEL // M_HEADS
M_DQK = M_DV // 2
M_QK = M_HEADS * M_DQK
M_V = M_HEADS * M_DV
M_PROJ = 2 * M_QK + 2 * M_V + 2 * M_HEADS
CONV_K = 4
IGATE_CAP = 15.0
HG_EXPAND = 128
HG_HEADS = D_MODEL // HG_EXPAND
HG_DK = HG_EXPAND
HG_DV = D_MODEL // HG_HEADS
HG_PROJ = 2 * HG_HEADS * HG_DK + 2 * D_MODEL
D_FF = 2816
N_EXPERTS = 8
TOP_K = 2
D_FF_EXPERT = D_FF // 2
EPS = 1e-6
NEG = -1e30
F_FLOOR = 1e-30

kernel_name = 'hybrid_mlstm_hgrn2_adaln_moe'


def rmsnorm(x, w):
    x32 = x.astype(jnp.float32)
    y = x32 * lax.rsqrt(jnp.mean(x32 * x32, axis=-1, keepdims=True) + EPS)
    return (y * w.astype(jnp.float32)).astype(x.dtype)


def head_rmsnorm(h, w):
    nh, dh = h.shape[1], h.shape[3]
    y = h * lax.rsqrt(jnp.mean(h * h, axis=-1, keepdims=True) + EPS)
    return y * w.astype(jnp.float32).reshape(1, nh, 1, dh)


def split_heads(a, nh):
    b, s, _ = a.shape
    return a.reshape(b, s, nh, -1).transpose(0, 2, 1, 3)


def merge_heads(a):
    b, h, s, d = a.shape
    return a.transpose(0, 2, 1, 3).reshape(b, s, h * d)


def to_chunks(a):
    b, h, s = a.shape[:3]
    return jnp.moveaxis(a.reshape((b, h, s // CHUNK, CHUNK) + a.shape[3:]), 2, 0)


def from_chunks(a):
    a = jnp.moveaxis(a, 0, 2)
    b, h, nc, l = a.shape[:4]
    return a.reshape((b, h, nc * l) + a.shape[4:])


def causal_conv(x, w, b):
    ch = x.shape[-1]
    y = lax.conv_general_dilated(x, w[:, None, :].astype(x.dtype), window_strides=(1,),
                                 padding=[(w.shape[0] - 1, 0)],
                                 dimension_numbers=('NWC', 'WIO', 'NWC'),
                                 feature_group_count=ch)
    return y + b.astype(x.dtype)


def mlstm_chunkwise(q, k, v, li, f_pre):
    bsz, nh, _, dk = q.shape
    dv = v.shape[-1]
    lf = jax.nn.log_sigmoid(f_pre)
    mask = jnp.tril(jnp.ones((CHUNK, CHUNK), dtype=bool))

    def step(carry, xs):
        c_st, n_st, m_st = carry
        qc, kc, vc, lic, lfc = xs
        b = jnp.cumsum(lfc, axis=-1)
        d = jnp.where(mask, b[..., :, None] - b[..., None, :] + lic[..., None, :], NEG)
        inter = b + m_st[..., None]
        m_t = jnp.maximum(inter, jnp.max(d, axis=-1))
        w_inter = jnp.exp(inter - m_t)
        s = jnp.einsum('bhtd,bhsd->bhts', qc, kc) * jnp.exp(d - m_t[..., None])
        num = (w_inter[..., None] * jnp.einsum('bhtd,bhdv->bhtv', qc, c_st)
               + jnp.einsum('bhts,bhsv->bhtv', s, vc))
        den = w_inter * jnp.einsum('bhtd,bhd->bht', qc, n_st) + jnp.sum(s, axis=-1)
        h = num / jnp.maximum(jnp.abs(den), jnp.exp(-m_t))[..., None]
        b_last = b[..., -1]
        dl = b_last[..., None] - b + lic
        m_new = jnp.maximum(b_last + m_st, jnp.max(dl, axis=-1))
        wk = jnp.exp(dl - m_new[..., None])
        decay = jnp.exp(b_last + m_st - m_new)
        c_new = decay[..., None, None] * c_st + jnp.einsum('bhs,bhsd,bhsv->bhdv', wk, kc, vc)
        n_new = decay[..., None] * n_st + jnp.einsum('bhs,bhsd->bhd', wk, kc)
        return (c_new, n_new, m_new), h

    init = (jnp.zeros((bsz, nh, dk, dv), jnp.float32),
            jnp.zeros((bsz, nh, dk), jnp.float32),
            jnp.zeros((bsz, nh), jnp.float32))
    _, hs = lax.scan(step, init, (to_chunks(q), to_chunks(k), to_chunks(v), to_chunks(li), to_chunks(lf)))
    return from_chunks(hs)


def hgrn2_chunkwise(q, k, log_f, v):
    bsz, nh, _, dk = q.shape
    dv = v.shape[-1]
    mask = jnp.tril(jnp.ones((CHUNK, CHUNK), dtype=bool))

    def step(s_st, xs):
        qc, kc, gc, vc = xs
        bc = jnp.cumsum(gc, axis=2)
        diff = bc[:, :, :, None, :] - bc[:, :, None, :, :]
        decay = jnp.exp(jnp.where(mask[:, :, None], diff, NEG))
        a = jnp.einsum('bhtd,bhsd,bhtsd->bhts', qc, kc, decay)
        o = (jnp.einsum('bhtd,bhdv->bhtv', qc * jnp.exp(bc), s_st)
             + jnp.einsum('bhts,bhsv->bhtv', a, vc))
        b_last = bc[:, :, -1]
        s_new = (jnp.exp(b_last)[..., None] * s_st
                 + jnp.einsum('bhsd,bhsv->bhdv', kc * jnp.exp(b_last[:, :, None] - bc), vc))
        return s_new, o

    init = jnp.zeros((bsz, nh, dk, dv), jnp.float32)
    _, os_ = lax.scan(step, init, (to_chunks(q), to_chunks(k), to_chunks(log_f), to_chunks(v)))
    return from_chunks(os_)


def mlstm_mixer(h, w_in, i_bias, f_bias, conv_w, conv_b, norm_w, w_out):
    proj = h @ w_in
    qk = jax.nn.silu(causal_conv(proj[..., :2 * M_QK], conv_w, conv_b))
    q = split_heads(qk[..., :M_QK], M_HEADS).astype(jnp.float32)
    k = split_heads(qk[..., M_QK:], M_HEADS).astype(jnp.float32) * (M_DQK ** -0.5)
    v = split_heads(proj[..., 2 * M_QK:2 * M_QK + M_V], M_HEADS).astype(jnp.float32)
    o = proj[..., 2 * M_QK + M_V:2 * M_QK + 2 * M_V]
    gates = proj[..., 2 * M_QK + 2 * M_V:].astype(jnp.float32)
    i_pre = gates[..., :M_HEADS] + i_bias.astype(jnp.float32)
    i_pre = IGATE_CAP * jnp.tanh(i_pre / IGATE_CAP)
    f_pre = gates[..., M_HEADS:] + f_bias.astype(jnp.float32)
    hh = mlstm_chunkwise(q, k, v, jnp.swapaxes(i_pre, 1, 2), jnp.swapaxes(f_pre, 1, 2))
    hh = merge_heads(head_rmsnorm(hh, norm_w)).astype(h.dtype) * jax.nn.sigmoid(o)
    return hh @ w_out


def hgrn2_mixer(h, w_in, lb, norm_w, w_out):
    proj = h @ w_in
    fd = HG_HEADS * HG_DK
    q = jax.nn.silu(proj[..., :fd]).astype(jnp.float32)
    f = proj[..., fd:2 * fd].astype(jnp.float32)
    i = proj[..., 2 * fd:2 * fd + D_MODEL].astype(jnp.float32)
    g = proj[..., 2 * fd + D_MODEL:]
    lb = lb.astype(jnp.float32)
    f_t = lb + (1.0 - lb) * jax.nn.sigmoid(f)
    log_f = jnp.log(jnp.maximum(f_t, F_FLOOR))
    k = (1.0 - lb) * jax.nn.sigmoid(-f)
    o = hgrn2_chunkwise(split_heads(q, HG_HEADS), split_heads(k, HG_HEADS),
                        split_heads(log_f, HG_HEADS), split_heads(i, HG_HEADS))
    o = merge_heads(head_rmsnorm(o, norm_w)).astype(h.dtype) * jax.nn.silu(g)
    return o @ w_out


def swiglu(t, wg, wu, wd):
    return (jax.nn.silu(t @ wg) * (t @ wu)) @ wd


def moe_swiglu(h, router_w, wg, wu, wd):
    bsz, s, d = h.shape
    t = h.reshape(bsz * s, d)
    logits = (t @ router_w).astype(jnp.float32)
    top_logits, top_idx = lax.top_k(logits, TOP_K)
    top_w = jax.nn.softmax(top_logits, axis=-1)
    gates = jnp.einsum('tk,tke->te', top_w, jax.nn.one_hot(top_idx, N_EXPERTS, dtype=jnp.float32)).astype(h.dtype)
    y = jnp.zeros_like(t)
    for e in range(N_EXPERTS):
        y = y + gates[:, e:e + 1] * swiglu(t, wg[e], wu[e], wd[e])
    return y.reshape(bsz, s, d)


def setup_inputs(seed: int = 0) -> dict:
    key = jax.random.key(seed)
    ks = iter(jax.random.split(key, 32))

    def nrm(shape, scale):
        return jax.random.normal(next(ks), shape, jnp.float32) * scale

    d = D_MODEL
    return {
        'x': nrm((BATCH, SEQ, d), 1.0),
        'c': nrm((BATCH, d), 1.0),
        'ada_w': nrm((DEPTH, d, 6 * d), 0.5 * d ** -0.5),
        'ada_b': nrm((DEPTH, 6 * d), 0.02),
        'norm1_w': 1.0 + nrm((DEPTH, d), 0.02),
        'norm2_w': 1.0 + nrm((DEPTH, d), 0.02),
        'final_norm_w': 1.0 + nrm((d,), 0.02),
        'm_w_in': nrm((N_MLSTM, d, M_PROJ), d ** -0.5),
        'm_i_bias': nrm((N_MLSTM, M_HEADS), 0.1),
        'm_f_bias': jnp.linspace(3.0, 6.0, M_HEADS, dtype=jnp.float32)[None, :] + nrm((N_MLSTM, M_HEADS), 0.1),
        'm_conv_w': nrm((N_MLSTM, CONV_K, 2 * M_QK), CONV_K ** -0.5),
        'm_conv_b': nrm((N_MLSTM, 2 * M_QK), 0.01),
        'm_norm_w': 1.0 + nrm((N_MLSTM, M_V), 0.02),
        'm_w_out': nrm((N_MLSTM, M_V, d), M_V ** -0.5),
        'h_w_in': nrm((N_HGRN, d, HG_PROJ), d ** -0.5),
        'h_lb_logits': nrm((N_HGRN, HG_HEADS * HG_DK), 0.5),
        'h_norm_w': 1.0 + nrm((N_HGRN, d), 0.02),
        'h_w_out': nrm((N_HGRN, d, d), d ** -0.5),
        'ffn_w_gate': nrm((N_MLSTM, d, D_FF), d ** -0.5),
        'ffn_w_up': nrm((N_MLSTM, d, D_FF), d ** -0.5),
        'ffn_w_down': nrm((N_MLSTM, D_FF, d), D_FF ** -0.5),
        'moe_router': nrm((N_HGRN, d, N_EXPERTS), d ** -0.5),
        'moe_w_gate': nrm((N_HGRN, N_EXPERTS, d, D_FF_EXPERT), d ** -0.5),
        'moe_w_up': nrm((N_HGRN, N_EXPERTS, d, D_FF_EXPERT), d ** -0.5),
        'moe_w_down': nrm((N_HGRN, N_EXPERTS, D_FF_EXPERT, d), D_FF_EXPERT ** -0.5),
    }


def reference(x, c, ada_w, ada_b, norm1_w, norm2_w, final_norm_w,
              m_w_in, m_i_bias, m_f_bias, m_conv_w, m_conv_b, m_norm_w, m_w_out,
              h_w_in, h_lb_logits, h_norm_w, h_w_out,
              ffn_w_gate, ffn_w_up, ffn_w_down,
              moe_router, moe_w_gate, moe_w_up, moe_w_down):
    cond = jax.nn.silu(c)
    gam = jax.nn.softmax(h_lb_logits.astype(jnp.float32), axis=0)
    lower_bounds = jnp.cumsum(gam, axis=0) - gam[:1]
    for layer in range(DEPTH):
        j = layer // N_MIXERS
        mod = (cond @ ada_w[layer] + ada_b[layer])[:, None, :]
        shift1, scale1, gate1, shift2, scale2, gate2 = jnp.split(mod, 6, axis=-1)
        hn = rmsnorm(x, norm1_w[layer]) * (1 + scale1) + shift1
        if layer % N_MIXERS == 0:
            y = mlstm_mixer(hn, m_w_in[j], m_i_bias[j], m_f_bias[j], m_conv_w[j], m_conv_b[j],
                            m_norm_w[j], m_w_out[j])
        else:
            y = hgrn2_mixer(hn, h_w_in[j], lower_bounds[j], h_norm_w[j], h_w_out[j])
        x = x + gate1 * y
        hn = rmsnorm(x, norm2_w[layer]) * (1 + scale2) + shift2
        if layer % 2 == 0:
            y = swiglu(hn, ffn_w_gate[j], ffn_w_up[j], ffn_w_down[j])
        else:
            y = moe_swiglu(hn, moe_router[j], moe_w_gate[j], moe_w_up[j], moe_w_down[j])
        x = x + gate2 * y
    return rmsnorm(x, final_norm_w)
```

```cpp
#include <hip/hip_runtime.h>
#include <cstdio>
#include <cstdint>

#ifndef MK_N_LAUNCHES
#define MK_N_LAUNCHES 1
#endif

#define LAS __attribute__((address_space(3)))
#define GAS __attribute__((address_space(1)))
typedef unsigned short bf16_t;
typedef short bf16x8 __attribute__((ext_vector_type(8)));
typedef float f32x4 __attribute__((ext_vector_type(4)));
typedef float f32x2 __attribute__((ext_vector_type(2)));
typedef unsigned u32x4 __attribute__((ext_vector_type(4)));
typedef unsigned u32x2 __attribute__((ext_vector_type(2)));

constexpr int BATCH = 8, SEQ = 4096, D = 1024, T = BATCH * SEQ;
constexpr int MPROJ = 3088, MPROJ_G = 3072;
constexpr int HPROJ = 4096;
constexpr int DFF = 2816, NE = 8, DFE = 1408;
constexpr float EPS = 1e-6f;
constexpr int XP = 2048;

constexpr size_t MiB = 1u << 20;
constexpr size_t WS_CTL = 0, CTL_ZERO_BYTES = 65536;
constexpr int CW_TMO = 0, CW_BAR = 4096, CW_CNT = 8192;
constexpr size_t WS_MOD = 1 * MiB;
constexpr size_t WS_LB = WS_MOD + (size_t)4 * 8 * 6144 * 4;
constexpr size_t WS_LI = 2 * MiB, WS_LF = 3 * MiB;
constexpr size_t WS_LTOK = 4 * MiB, WS_LW = 5 * MiB;
constexpr size_t WS_RS = 6 * MiB, WS_KN = 7 * MiB;
constexpr size_t WS_WGT = 8 * MiB;
constexpr size_t W_MIN = 0;
constexpr size_t W_MGATE = W_MIN + (size_t)3072 * 1024 * 2;
constexpr size_t W_MOUT = W_MGATE + 16 * 1024 * 4;
constexpr size_t W_FGU = W_MOUT + (size_t)1024 * 1024 * 2;
constexpr size_t W_FD = W_FGU + (size_t)5632 * 1024 * 2;
constexpr size_t W_HIN = W_FD + (size_t)1024 * 2816 * 2;
constexpr size_t W_HOUT = W_HIN + (size_t)4096 * 1024 * 2;
constexpr size_t W_ROUT = W_HOUT + (size_t)1024 * 1024 * 2;
constexpr size_t W_EGU = W_ROUT + 8 * 1024 * 4;
constexpr size_t W_ED = W_EGU + (size_t)8 * 2816 * 1024 * 2;
constexpr size_t LP_BYTES = W_ED + (size_t)8 * 1024 * 1408 * 2;
constexpr size_t WS_R1 = ((WS_WGT + 2 * LP_BYTES + MiB - 1) / MiB) * MiB;
constexpr size_t WS_R2 = WS_R1 + 256 * MiB;
constexpr size_t WS_END = WS_R2 + 128 * MiB;
constexpr size_t WS_SCT = WS_END, WS_SCI = WS_END + 4 * MiB, WS_END2 = WS_END + 8 * MiB;
constexpr size_t WS_R2U = WS_R2 + 64 * MiB;
static_assert(LP_BYTES % 16 == 0 && W_MGATE % 16 == 0 && W_ROUT % 16 == 0, "alignment");

constexpr int LDS_BYTES = 163840;
constexpr int MISC_OFF = LDS_BYTES - 256;

__device__ __forceinline__ float bf2f_lo(unsigned w) { return __builtin_bit_cast(float, w << 16); }
__device__ __forceinline__ float bf2f_hi(unsigned w) { return __builtin_bit_cast(float, w & 0xffff0000u); }
__device__ __forceinline__ float bf2f(unsigned short u) { return __builtin_bit_cast(float, (unsigned)u << 16); }
__device__ __forceinline__ unsigned f2bf(float f) { unsigned u = __builtin_bit_cast(unsigned, f); return (u + 0x7fffu + ((u >> 16) & 1u)) >> 16; }
__device__ __forceinline__ unsigned pk2(float lo, float hi) { unsigned r; asm volatile("v_cvt_pk_bf16_f32 %0, %1, %2" : "=v"(r) : "v"(lo), "v"(hi)); return r; }
typedef __bf16 bf16x2_t __attribute__((ext_vector_type(2)));
__device__ __forceinline__ unsigned pk2_acc(float lo, float hi) { const f32x2 v = {lo, hi}; const bf16x2_t b = __builtin_convertvector(v, bf16x2_t); return __builtin_bit_cast(unsigned, b); }
__device__ __forceinline__ float wave_sum(float v) {
#pragma unroll
    for (int o = 1; o < 64; o <<= 1) v += __shfl_xor(v, o);
    return v;
}
__device__ __forceinline__ float sigmoidf_(float x) { return __builtin_amdgcn_rcpf(1.f + __expf(-x)); }
__device__ __forceinline__ float siluf_(float x) { return x * __builtin_amdgcn_rcpf(1.f + __expf(-x)); }
__device__ __forceinline__ int lane_id() { return (int)__builtin_amdgcn_mbcnt_hi(~0u, __builtin_amdgcn_mbcnt_lo(~0u, 0u)); }
__device__ __forceinline__ int opaque_v(int x) { asm volatile("" : "+v"(x)); return x; }
__device__ __forceinline__ int opaque_s(int x) { asm volatile("" : "+s"(x)); return x; }
__device__ __forceinline__ float rows4_sum(float p) { p += __shfl_xor(p, 16); p += __shfl_xor(p, 32); return p; }
#define MFMA16(a, b, c) __builtin_amdgcn_mfma_f32_16x16x32_bf16((a), (b), (c), 0, 0, 0)
#define LDS_ADDF(p, v) __hip_atomic_fetch_add((p), (v), __ATOMIC_RELAXED, __HIP_MEMORY_SCOPE_WORKGROUP)

namespace pg8 {
#define PG8_LAS __attribute__((address_space(3)))
constexpr int BM = 256, BK = 64, HALF = 128, HTB = HALF * BK * 2, STAGE_BYTES = 8 * HTB, NXCD = 8, WGM = 8;
__host__ __device__ __forceinline__ int lds_byte(int r, int c) { const int st = (r >> 4) * 2 + (c >> 5), rr = r & 15, cc = c & 31, ob = rr * 64 + cc * 2; return st * 1024 + (ob ^ (((ob >> 9) & 1) << 5)); }
__host__ __device__ __forceinline__ void stage_rc(int b, int& R, int& C) { const int st = b / 1024, sb = b % 1024, swz = sb ^ (((sb >> 9) & 1) << 5); R = (st >> 1) * 16 + swz / 64; C = (st & 1) * 32 + (swz % 64) / 2; }
__host__ __device__ __forceinline__ int perm32(int rho) { const int n = rho >> 4, i = rho & 15; return 8 * (i >> 2) + 4 * n + (i & 3); }

struct Unit { int pm, pn, e, lrow; };
struct Gemm { const bf16_t* A; const bf16_t* Bt; int M, N, K; size_t bexp; };

struct StaticOrder {
    int nM, nN, nwg, G, c;
    __device__ __forceinline__ void init(int M, int N, int G_, int c_) { nM = M / BM; nN = N / BM; nwg = nM * nN; G = G_; c = c_; }
    __device__ __forceinline__ bool next(int i, Unit& u) const {
        const long L = (long)i * G + c; if (L >= nwg) return false;
        int wgid = (int)L; { const int q = nwg / NXCD, r = nwg % NXCD, xcd = wgid % NXCD, off = wgid / NXCD; wgid = (xcd < r ? xcd * (q + 1) : r * (q + 1) + (xcd - r) * q) + off; }
        const int nig = WGM * nN, gid = wgid / nig, fm = gid * WGM, gsz = (nM - fm) < WGM ? (nM - fm) : WGM;
        u.pm = fm + ((wgid % nig) % gsz); u.pn = (wgid % nig) / gsz; u.e = 0; u.lrow = 0; return true;
    }
    __device__ __forceinline__ int row_index(const Unit&, int) const { return 0; }
};
struct MoeOrder {
    int nM, nN, nwg, G, c; const PG8_LAS int* tab; const int* lst; const unsigned* cnt;
    __device__ __forceinline__ void init(const unsigned* cnt_, const int* lst_, int nN_, int G_, int c_, PG8_LAS int* tab_, int wid) {
        if (wid == 0 && lane_id() == 0) { int acc = 0; tab_[0] = 0;
            for (int e = 0; e < 8; ++e) { int v = (int)cnt_[e]; v = v < 0 ? 0 : (v > T ? T : v); tab_[16 + e] = v; acc += (v + 255) / 256; tab_[e + 1] = acc; } }
        __syncthreads();
        tab = tab_; nM = tab_[8]; nN = nN_; nwg = nM * nN; G = G_; c = c_; lst = lst_; cnt = cnt_;
    }
    __device__ __forceinline__ bool next(int i, Unit& u) const {
        const long L = (long)i * G + c; if (L >= nwg) return false;
        int wgid = (int)L; { const int q = nwg / NXCD, r = nwg % NXCD, xcd = wgid % NXCD, off = wgid / NXCD; wgid = (xcd < r ? xcd * (q + 1) : r * (q + 1) + (xcd - r) * q) + off; }
        const int nig = WGM * nN, gid = wgid / nig, fm = gid * WGM, gsz = (nM - fm) < WGM ? (nM - fm) : WGM;
        u.pm = fm + ((wgid % nig) % gsz); u.pn = (wgid % nig) / gsz;
        int e = 0;
        for (int k = 1; k < 8; ++k) { if (u.pm >= tab[k]) e = k; }
        u.e = e; u.lrow = (u.pm - tab[e]) * 256; return true;
    }
    __device__ __forceinline__ int row_index(const Unit& u, int r) const {
        const int pos = u.lrow + r; const int n = tab[16 + u.e];
        int v = 0; if (pos < n) v = lst[(size_t)u.e * T + pos] >> 1;
        return v;
    }
};

template <int MODE> struct EpiBf16 {
    static constexpr bool PERM = true, AFTER_DRAIN = false;
    bf16_t* O; int ldc; const float* lb;
    __device__ __forceinline__ void operator()(const f32x4 (&acc)[2][2][4][2], const Unit& u, int wr, int wc, int fr, int fq) const {
        const int row0 = u.pm * BM + wr * 64 + fr; const int col0 = u.pn * BM + wc * 32 + 8 * fq;
        const int kind = (MODE == 1) ? (u.pn >> 2) : 2;
        f32x4 lbv[2][2];
        if (MODE == 1 && kind == 1) {
#pragma unroll
            for (int bj = 0; bj < 2; ++bj)
#pragma unroll
                for (int n = 0; n < 2; ++n) lbv[bj][n] = lb ? *(const f32x4*)(lb + (col0 - 1024) + bj * HALF + 4 * n) : (f32x4){0.f, 0.f, 0.f, 0.f};
        }
#pragma unroll
        for (int ai = 0; ai < 2; ++ai)
#pragma unroll
            for (int m = 0; m < 4; ++m) { bf16_t* rowp = O + (size_t)(row0 + ai * HALF + m * 16) * ldc + col0;
#pragma unroll
                for (int bj = 0; bj < 2; ++bj) { f32x4 v0 = acc[ai][bj][m][0], v1 = acc[ai][bj][m][1];
                    if (MODE == 1) {
                        if (kind == 0 || kind == 2) {
#pragma unroll
                            for (int j = 0; j < 4; ++j) { v0[j] = siluf_(v0[j]); v1[j] = siluf_(v1[j]); }
                        } else if (kind == 1) {
#pragma unroll
                            for (int j = 0; j < 4; ++j) { const float l0 = lbv[bj][0][j], l1 = lbv[bj][1][j];
                                v0[j] = logf(fmaxf(l0 + (1.f - l0) * sigmoidf_(v0[j]), 1e-30f)); v1[j] = logf(fmaxf(l1 + (1.f - l1) * sigmoidf_(v1[j]), 1e-30f)); }
                        }
                    }
                    u32x4 w; w.x = pk2(v0[0], v0[1]); w.y = pk2(v0[2], v0[3]); w.z = pk2(v1[0], v1[1]); w.w = pk2(v1[2], v1[3]);
                    *(u32x4*)(rowp + bj * HALF) = w; } }
    }
};
template <int KIND> struct EpiTile {
    static constexpr bool PERM = true, AFTER_DRAIN = false;
    bf16_t* QK; bf16_t* OG; const float* lb;
    __device__ __forceinline__ void operator()(const f32x4 (&acc)[2][2][4][2], const Unit& u, int wr, int wc, int fr, int fq) const {
        constexpr int HD = (KIND == 0) ? 64 : 128, NQK = 2 * 8 * HD;
        const int row0 = u.pm * BM + wr * 64 + fr;
#pragma unroll
        for (int bj = 0; bj < 2; ++bj) { const int c = u.pn * BM + bj * HALF + wc * 32 + 8 * fq;
            const bool isqk = c < NQK; const int which = isqk ? (c / (8 * HD)) : 0; const int cc = isqk ? (c % (8 * HD)) : (c - NQK);
            const int h = isqk ? (cc / HD) : (cc >> 7), d = isqk ? (cc % HD) : (cc & 127);
            f32x4 l0 = (f32x4){0.f, 0.f, 0.f, 0.f}, l1 = l0;
            if (KIND == 1 && isqk && which == 1 && lb) { l0 = *(const f32x4*)(lb + h * 128 + d); l1 = *(const f32x4*)(lb + h * 128 + d + 4); }
            if (KIND == 0 && !isqk) { l0 = *(const f32x4*)(lb + h * 128 + d); l1 = *(const f32x4*)(lb + h * 128 + d + 4); }
#pragma unroll
            for (int ai = 0; ai < 2; ++ai)
#pragma unroll
                for (int m = 0; m < 4; ++m) { const int r = row0 + ai * HALF + m * 16; const int item = (((r >> 12) * 8 + h) << 6) + ((r >> 6) & 63), t = r & 63;
                    f32x4 v0 = acc[ai][bj][m][0], v1 = acc[ai][bj][m][1];
                    if (KIND == 0 && !isqk) {
#pragma unroll
                        for (int j = 0; j < 4; ++j) { v0[j] = sigmoidf_(v0[j]) * l0[j]; v1[j] = sigmoidf_(v1[j]) * l1[j]; }
                    }
                    if (KIND == 1) {
                        if (isqk && which == 1) {
#pragma unroll
                            for (int j = 0; j < 4; ++j) { v0[j] = __logf(fmaxf(l0[j] + (1.f - l0[j]) * sigmoidf_(v0[j]), 1e-30f)); v1[j] = __logf(fmaxf(l1[j] + (1.f - l1[j]) * sigmoidf_(v1[j]), 1e-30f)); }
                        } else {
#pragma unroll
                            for (int j = 0; j < 4; ++j) { v0[j] = siluf_(v0[j]); v1[j] = siluf_(v1[j]); }
                        }
                    }
                    u32x4 w; w.x = pk2(v0[0], v0[1]); w.y = pk2(v0[2], v0[3]); w.z = pk2(v1[0], v1[1]); w.w = pk2(v1[2], v1[3]);
                    bf16_t* p = isqk ? (QK + ((size_t)(item * 2 + which) * 64 + t) * HD + d) : (OG + ((size_t)item * 64 + t) * 128 + d);
                    *(u32x4*)p = w; } }
    }
};
struct EpiVT {
    static constexpr bool PERM = true, AFTER_DRAIN = false;
    bf16_t* VT;
    __device__ __forceinline__ void operator()(const f32x4 (&acc)[2][2][4][2], const Unit& u, int wr, int wc, int fr, int fq) const {
        const int row0 = u.pm * BM + wr * 64 + fr;
#pragma unroll
        for (int bj = 0; bj < 2; ++bj) { const int tok = u.pn * BM + bj * HALF + wc * 32 + 8 * fq; const int b = tok >> 12, ch = (tok >> 6) & 63, s = tok & 63;
#pragma unroll
            for (int ai = 0; ai < 2; ++ai)
#pragma unroll
                for (int m = 0; m < 4; ++m) { const int c = row0 + ai * HALF + m * 16; const int h = c >> 7, dv = c & 127; const int item = ((b * 8 + h) << 6) + ch;
                    const f32x4 v0 = acc[ai][bj][m][0], v1 = acc[ai][bj][m][1];
                    u32x4 w; w.x = pk2(v0[0], v0[1]); w.y = pk2(v0[2], v0[3]); w.z = pk2(v1[0], v1[1]); w.w = pk2(v1[2], v1[3]);
                    *(u32x4*)(VT + ((size_t)item * 128 + dv) * 64 + s) = w; } }
    }
};
template <bool XIN_F32> struct EpiResid {
    static constexpr bool PERM = true, AFTER_DRAIN = false;
    const void* xin; bf16_t* xout; const float* gate;
    __device__ __forceinline__ void operator()(const f32x4 (&acc)[2][2][4][2], const Unit& u, int wr, int wc, int fr, int fq) const {
        const int row0 = u.pm * BM + wr * 64 + fr, col0 = u.pn * BM + wc * 32 + 8 * fq; const int b = u.pm >> 4;
        f32x4 gv[2][2];
#pragma unroll
        for (int bj = 0; bj < 2; ++bj)
#pragma unroll
            for (int n = 0; n < 2; ++n) gv[bj][n] = *(const f32x4*)(gate + (size_t)b * 6144 + col0 + bj * HALF + n * 4);
#pragma unroll
        for (int ai = 0; ai < 2; ++ai)
#pragma unroll
            for (int m = 0; m < 4; ++m) { const size_t row = (size_t)(row0 + ai * HALF + m * 16);
#pragma unroll
                for (int bj = 0; bj < 2; ++bj) { f32x4 x0, x1;
                    if (XIN_F32) { const float* p = (const float*)xin + row * D + col0 + bj * HALF; x0 = *(const f32x4*)p; x1 = *(const f32x4*)(p + 4); }
                    else { const u32x4 v = *(const u32x4*)((const bf16_t*)xin + row * XP + col0 + bj * HALF);
                        x0 = (f32x4){bf2f_lo(v.x), bf2f_hi(v.x), bf2f_lo(v.y), bf2f_hi(v.y)}; x1 = (f32x4){bf2f_lo(v.z), bf2f_hi(v.z), bf2f_lo(v.w), bf2f_hi(v.w)}; }
                    x0 = x0 + gv[bj][0] * acc[ai][bj][m][0]; x1 = x1 + gv[bj][1] * acc[ai][bj][m][1];
                    u32x4 o; o.x = pk2(x0[0], x0[1]); o.y = pk2(x0[2], x0[3]); o.z = pk2(x1[0], x1[1]); o.w = pk2(x1[2], x1[3]);
                    *(u32x4*)(xout + row * XP + col0 + bj * HALF) = o; } }
    }
};
struct EpiSwiGLU {
    static constexpr bool PERM = true, AFTER_DRAIN = false;
    bf16_t* O; int ldc;
    __device__ __forceinline__ void operator()(const f32x4 (&acc)[2][2][4][2], const Unit& u, int wr, int wc, int fr, int fq) const {
        const int row0 = u.pm * BM + wr * 64 + fr; const int col0 = u.pn * HALF + wc * 32 + 8 * fq;
#pragma unroll
        for (int ai = 0; ai < 2; ++ai)
#pragma unroll
            for (int m = 0; m < 4; ++m) { bf16_t* rowp = O + (size_t)(row0 + ai * HALF + m * 16) * ldc + col0;
                f32x4 v0, v1;
#pragma unroll
                for (int j = 0; j < 4; ++j) { v0[j] = siluf_(acc[ai][0][m][0][j]) * acc[ai][1][m][0][j]; v1[j] = siluf_(acc[ai][0][m][1][j]) * acc[ai][1][m][1][j]; }
                u32x4 w; w.x = pk2(v0[0], v0[1]); w.y = pk2(v0[2], v0[3]); w.z = pk2(v1[0], v1[1]); w.w = pk2(v1[2], v1[3]);
                *(u32x4*)rowp = w; }
    }
};
struct EpiMoeDown {
    static constexpr bool PERM = true, AFTER_DRAIN = false;
    bf16_t* Y; const int* lst; const float* lw; const unsigned* cnt; const float* gate;
    __device__ __forceinline__ void operator()(const f32x4 (&acc)[2][2][4][2], const Unit& u, int wr, int wc, int fr, int fq) const {
        const int col0 = u.pn * BM + wc * 32 + 8 * fq; const int n_e = (int)cnt[u.e];
#pragma unroll
        for (int ai = 0; ai < 2; ++ai)
#pragma unroll
            for (int m = 0; m < 4; ++m) { const int pos = u.lrow + ai * HALF + wr * 64 + m * 16 + fr;
                if (pos < n_e) {
                    const int ts = lst[(size_t)u.e * T + pos]; const float w = lw[(size_t)u.e * T + pos]; const int b = ts >> 13;
                    bf16_t* rowp = Y + (size_t)ts * D + col0; const float* gp = gate + (size_t)b * 6144 + col0;
#pragma unroll
                    for (int bj = 0; bj < 2; ++bj) { const f32x4 g0 = *(const f32x4*)(gp + bj * HALF), g1 = *(const f32x4*)(gp + bj * HALF + 4);
                        const f32x4 v0 = acc[ai][bj][m][0] * g0 * w, v1 = acc[ai][bj][m][1] * g1 * w;
                        u32x4 o; o.x = pk2(v0[0], v0[1]); o.y = pk2(v0[2], v0[3]); o.z = pk2(v1[0], v1[1]); o.w = pk2(v1[2], v1[3]);
                        *(u32x4*)(rowp + bj * HALF) = o; } } }
    }
};

template <class Epi, class Sched, bool ALIGN_EPI, bool GATHER>
__device__ __forceinline__ void gemm_phase(PG8_LAS unsigned char* lds, const Gemm g, const Sched& S, const Epi& E, const int wid) {
    const int lane = opaque_v(lane_id()), tid = wid * 64 + lane, wr = wid >> 2, wc = wid & 3, fr = lane & 15, fq = lane >> 4;
    const int K = g.K, nt = K / BK;
    unsigned voffA[2], voffB[2];
#pragma unroll
    for (int i = 0; i < 2; ++i) { int R, C; stage_rc(tid * 16 + i * 8192, R, C); const int Rb = Epi::PERM ? ((R & ~31) + perm32(R & 31)) : R;
        voffA[i] = (unsigned)(R * K + C) * 2u; voffB[i] = (unsigned)(Rb * K + C) * 2u; }
    const size_t kstep = (size_t)(BK * 2);
    const size_t hstep = (size_t)HALF * K * 2;
    const size_t tstep = 2 * hstep;
    const unsigned ldsw = (unsigned)wid * 1024u;
    const int aoff = lds_byte(wr * 64 + fr, fq * 8), boff = lds_byte(wc * 32 + fr, fq * 8);
#define PG8_SA(b, h) (((b) * 2 + (h)) * HTB)
#define PG8_SB(b, h) ((4 + (b) * 2 + (h)) * HTB)
#define PG8_GL(gp, ldsoff) __builtin_amdgcn_global_load_lds((const unsigned*)(gp), (PG8_LAS unsigned*)(lds + (ldsoff)), 16, 0, 0)
#define PG8_STAGE(bufoff, gbase, voff) do { _Pragma("unroll") for (int _i = 0; _i < 2; ++_i) PG8_GL((const char*)(gbase) + (voff)[_i], (bufoff) + ldsw + _i * 8192); } while (0)
#define PG8_STAGE_A(bufoff, h, kofs, nx) do { if constexpr (GATHER) { _Pragma("unroll") for (int _i = 0; _i < 2; ++_i) PG8_GL((const char*)g.A + (kofs) + vA[h][_i], (bufoff) + ldsw + _i * 8192); } \
        else { const char* _b = ((nx) ? nA : cA) + (size_t)(h) * hstep + (kofs); PG8_STAGE(bufoff, _b, voffA); } } while (0)
#define PG8_GOFF(dst, uu) do { _Pragma("unroll") for (int _h = 0; _h < 2; ++_h) _Pragma("unroll") for (int _i = 0; _i < 2; ++_i) { int _R, _C; stage_rc(tid * 16 + _i * 8192, _R, _C); \
        const int _tok = S.row_index(uu, _h * HALF + _R); dst[_h][_i] = (unsigned)(_tok * K + _C) * 2u; } } while (0)
#define PG8_LDA(dst, b, h) do { _Pragma("unroll") for (int m = 0; m < 4; ++m) _Pragma("unroll") for (int k = 0; k < 2; ++k) dst[m][k] = *(const PG8_LAS bf16x8*)(lds + PG8_SA(b, h) + aoff + m * 2048 + k * 1024); } while (0)
#define PG8_LDB(dst, b, h) do { _Pragma("unroll") for (int n = 0; n < 2; ++n) _Pragma("unroll") for (int k = 0; k < 2; ++k) dst[n][k] = *(const PG8_LAS bf16x8*)(lds + PG8_SB(b, h) + boff + n * 2048 + k * 1024); } while (0)
#define PG8_MMA(ai, bj, At, Bt) do { __builtin_amdgcn_s_setprio(1); _Pragma("unroll") for (int m = 0; m < 4; ++m) _Pragma("unroll") for (int n = 0; n < 2; ++n) _Pragma("unroll") for (int k = 0; k < 2; ++k) \
        acc[ai][bj][m][n] = __builtin_amdgcn_mfma_f32_16x16x32_bf16(Bt[n][k], At[m][k], acc[ai][bj][m][n], 0, 0, 0); __builtin_amdgcn_s_setprio(0); } while (0)
#define PG8_WAIT_V(n) asm volatile("s_waitcnt vmcnt(" #n ")" ::: "memory")
#define PG8_WAIT_L(n) asm volatile("s_waitcnt lgkmcnt(" #n ")" ::: "memory")
#define PG8_BAR __builtin_amdgcn_s_barrier()
#define PG8_SCHED __builtin_amdgcn_sched_barrier(0)
    Unit cur, nxt; int ui = 0;
    if (!S.next(0, cur)) return;
    f32x4 acc[2][2][4][2];
#pragma unroll
    for (int a = 0; a < 2; ++a)
#pragma unroll
        for (int b = 0; b < 2; ++b)
#pragma unroll
            for (int m = 0; m < 4; ++m)
#pragma unroll
                for (int n = 0; n < 2; ++n) acc[a][b][m][n] = (f32x4){0.f, 0.f, 0.f, 0.f};
    bf16x8 At[4][2], B0[2][2], B1[2][2];
    unsigned vA[2][2];
    const char* cA = (const char*)g.A + (GATHER ? (size_t)0 : (size_t)cur.pm * tstep);
    const char* cB = (const char*)g.Bt + ((size_t)cur.e * g.bexp) * 2 + (size_t)cur.pn * tstep;
    const char* nA = cA;
    if constexpr (GATHER) { PG8_GOFF(vA, cur); }
    PG8_STAGE(PG8_SB(0, 0), cB, voffB); PG8_STAGE(PG8_SB(0, 1), cB + hstep, voffB); PG8_STAGE_A(PG8_SA(0, 0), 0, 0, false); PG8_STAGE_A(PG8_SA(0, 1), 1, 0, false);
    if (wr == 1) PG8_BAR;
    PG8_WAIT_V(2); PG8_BAR;
    PG8_STAGE(PG8_SB(1, 0), cB + kstep, voffB); PG8_STAGE_A(PG8_SA(1, 0), 0, kstep, false); PG8_STAGE(PG8_SB(1, 1), cB + hstep + kstep, voffB);
    PG8_WAIT_V(6); PG8_BAR;
    for (;;) {
        const bool has_next = S.next(ui + 1, nxt);
        const char* nB = has_next ? (const char*)g.Bt + ((size_t)nxt.e * g.bexp) * 2 + (size_t)nxt.pn * tstep : cB;
        if constexpr (!GATHER) nA = has_next ? (const char*)g.A + (size_t)nxt.pm * tstep : cA;
        if constexpr (GATHER) { if (has_next) { unsigned _t[2][2]; PG8_GOFF(_t, nxt); *(PG8_LAS u32x4*)(lds + STAGE_BYTES + tid * 16) = (u32x4){_t[0][0], _t[0][1], _t[1][0], _t[1][1]}; } }
        for (int t = 0; t < nt; t += 2) {
            const bool last = (t == nt - 2);
            const size_t k1 = (size_t)(t + 1) * kstep;
            const size_t k2 = last ? (size_t)0 : (size_t)(t + 2) * kstep, k3 = k2 + kstep;
            const char* b2 = last ? nB : cB + (size_t)(t + 2) * kstep; const char* b3 = b2 + kstep;
            PG8_LDB(B0, 0, 0); PG8_LDB(B1, 0, 1); PG8_SCHED; PG8_LDA(At, 0, 0); PG8_STAGE_A(PG8_SA(1, 1), 1, k1, false);
            if constexpr (GATHER) { if (last && has_next) { const u32x4 _v = *(const PG8_LAS u32x4*)(lds + STAGE_BYTES + tid * 16); vA[0][0] = _v.x; vA[0][1] = _v.y; vA[1][0] = _v.z; vA[1][1] = _v.w; } }
            PG8_WAIT_V(8); PG8_WAIT_L(0); PG8_BAR; PG8_MMA(0, 0, At, B0); PG8_MMA(0, 1, At, B1); PG8_BAR; PG8_SCHED;
            PG8_LDA(At, 0, 1); PG8_STAGE(PG8_SB(0, 0), b2, voffB); PG8_STAGE(PG8_SB(0, 1), b2 + hstep, voffB); PG8_STAGE_A(PG8_SA(0, 0), 0, k2, last);
            PG8_WAIT_V(8); PG8_WAIT_L(0); PG8_BAR; PG8_MMA(1, 0, At, B0); PG8_MMA(1, 1, At, B1); PG8_BAR; PG8_SCHED;
            PG8_LDB(B0, 1, 0); PG8_LDB(B1, 1, 1); PG8_SCHED; PG8_LDA(At, 1, 0); PG8_STAGE_A(PG8_SA(0, 1), 1, k2, last);
            PG8_WAIT_V(8); PG8_WAIT_L(0); PG8_BAR; PG8_MMA(0, 0, At, B0); PG8_MMA(0, 1, At, B1); PG8_BAR; PG8_SCHED;
            PG8_LDA(At, 1, 1); PG8_STAGE(PG8_SB(1, 0), b3, voffB); PG8_STAGE(PG8_SB(1, 1), b3 + hstep, voffB); PG8_STAGE_A(PG8_SA(1, 0), 0, k3, last);
            PG8_WAIT_V(8); PG8_WAIT_L(0); PG8_BAR; PG8_MMA(1, 0, At, B0); PG8_MMA(1, 1, At, B1); PG8_BAR; PG8_SCHED;
        }
        if constexpr (ALIGN_EPI) { if (wr == 0) PG8_BAR; }
        E(acc, cur, wr, wc, fr, fq);
        if (!has_next) break;
#pragma unroll
        for (int a = 0; a < 2; ++a)
#pragma unroll
            for (int b = 0; b < 2; ++b)
#pragma unroll
                for (int m = 0; m < 4; ++m)
#pragma unroll
                    for (int n = 0; n < 2; ++n) acc[a][b][m][n] = (f32x4){0.f, 0.f, 0.f, 0.f};
        cur = nxt; cA = nA; cB = nB; ++ui;
        if constexpr (ALIGN_EPI) { if (wr == 1) PG8_BAR; }
    }
    PG8_WAIT_V(0);
    if constexpr (!ALIGN_EPI) { if (wr == 0) PG8_BAR; }
    PG8_BAR;
#undef PG8_SA
#undef PG8_SB
#undef PG8_GL
#undef PG8_STAGE
#undef PG8_STAGE_A
#undef PG8_GOFF
#undef PG8_LDA
#undef PG8_LDB
#undef PG8_MMA
#undef PG8_WAIT_V
#undef PG8_WAIT_L
#undef PG8_BAR
#undef PG8_SCHED
}
}

#define XB_TMO      128
#define XB_XCNT(j)  (256  + 64 * (j))
#define XB_XSUB(j)  (1280 + 64 * (j))
#define XB_XGEN(j)  (2304 + 64 * (j))
#define XB_TOP      3328
#define XB_TOPGEN   3392
#define XCD_BAR_WORDS 3456
#define XB_SPIN_CAP (1u << 18)
__device__ __forceinline__ unsigned xb_ld(unsigned* p)              { return __hip_atomic_load(p, __ATOMIC_RELAXED, __HIP_MEMORY_SCOPE_AGENT); }
__device__ __forceinline__ unsigned xb_add(unsigned* p, unsigned v) { return __hip_atomic_fetch_add(p, v, __ATOMIC_RELAXED, __HIP_MEMORY_SCOPE_AGENT); }
__device__ __forceinline__ unsigned xb_xcc_id() { return (unsigned)__builtin_amdgcn_s_getreg((3 << 11) | 20) & 0xFu; }
#define XB_SPIN(cond, bar) do { unsigned _sp = 0; while (cond) { __builtin_amdgcn_s_sleep(1); \
    if ((++_sp & 255u) == 0u) { if (xb_ld(&(bar)[XB_TMO])) break; if (_sp > XB_SPIN_CAP) { atomicAdd(&(bar)[XB_TMO], 1u); break; } } } } while (0)
struct XcdBarrier { unsigned* bar; unsigned x; volatile LAS unsigned* st; int wv; };
__device__ __forceinline__ XcdBarrier xcd_barrier_post(unsigned* bar, volatile LAS unsigned* st, int wv) {
    XcdBarrier b; b.bar = bar; b.x = xb_xcc_id(); b.st = st; b.wv = wv;
    if (wv == 0 && lane_id() == 0) (void)xb_add(&bar[XB_XCNT(b.x)], 1u);
    return b;
}
__device__ __forceinline__ void xcd_barrier_complete(unsigned* bar, unsigned x, unsigned& nloc, unsigned& nx) {
    const unsigned G = gridDim.x * gridDim.y * gridDim.z;
    unsigned sum, cnt, mine, sp = 0u;
    for (;;) {
        sum = 0u; cnt = 0u; mine = 0u;
#pragma unroll
        for (unsigned j = 0; j < 16; ++j) { const unsigned c = xb_ld(&bar[XB_XCNT(j)]); sum += c; cnt += (c > 0u) ? 1u : 0u; mine = (j == x) ? c : mine; }
        if (sum == G) break;
        __builtin_amdgcn_s_sleep(1);
        if ((++sp & 255u) == 0u) { if (xb_ld(&bar[XB_TMO])) break; if (sp > XB_SPIN_CAP) { atomicAdd(&bar[XB_TMO], 1u); break; } }
    }
    nloc = mine > 0u ? mine : 1u; nx = cnt > 0u ? cnt : 1u;
}
__device__ __forceinline__ void xcd_barrier(const XcdBarrier& b) {
    asm volatile("s_waitcnt vmcnt(0)" ::: "memory");
    __syncthreads();
    if (b.wv == 0 && lane_id() == 0) {
        unsigned* bar = b.bar;
        __builtin_amdgcn_s_waitcnt(0);
        unsigned nloc = b.st[0], nx = b.st[1];
        if (nloc == 0u) { xcd_barrier_complete(bar, b.x, nloc, nx); b.st[0] = nloc; b.st[1] = nx; }
        const unsigned old = xb_add(&bar[XB_XSUB(b.x)], 1u);
        const unsigned gen = old / nloc;
        if (old + 1u == (gen + 1u) * nloc) {
            __builtin_amdgcn_fence(__ATOMIC_RELEASE, "agent");
            asm volatile("s_waitcnt vmcnt(0)" ::: "memory");
            const unsigned og = xb_add(&bar[XB_TOP], 1u);
            const unsigned tg = og / nx;
            if (og + 1u == (tg + 1u) * nx) xb_add(&bar[XB_TOPGEN], 1u);
            else XB_SPIN(xb_ld(&bar[XB_TOPGEN]) == tg, bar);
            __builtin_amdgcn_fence(__ATOMIC_ACQUIRE, "agent");
            xb_add(&bar[XB_XGEN(b.x)], 1u);
            asm volatile("s_waitcnt vmcnt(0)" ::: "memory");
        } else {
            XB_SPIN(xb_ld(&bar[XB_XGEN(b.x)]) == gen, bar);
            __builtin_amdgcn_fence(__ATOMIC_ACQUIRE, "agent");
            asm volatile("s_waitcnt vmcnt(0)" ::: "memory");
        }
    }
    __syncthreads();
}

struct Args { const float* in[25]; float* out; unsigned char* ws; int ph_lo, ph_hi; };
typedef const __attribute__((address_space(4))) unsigned char* kseg_t;
__device__ __forceinline__ kseg_t kseg() { kseg_t p = (kseg_t)__builtin_amdgcn_kernarg_segment_ptr(); asm volatile("" : "+s"(p)); return p; }
__device__ __forceinline__ const float* karg(int i) { return *(const float* const __attribute__((address_space(4)))*)(kseg() + 8 * i); }
__device__ __forceinline__ float* kout() { return *(float* const __attribute__((address_space(4)))*)(kseg() + 8 * 25); }
__device__ __forceinline__ unsigned char* kws() { return *(unsigned char* const __attribute__((address_space(4)))*)(kseg() + 8 * 26); }
enum { I_X = 0, I_C, I_ADAW, I_ADAB, I_N1W, I_N2W, I_FNW, I_MWIN, I_MIB, I_MFB, I_MCW, I_MCB, I_MNW, I_MWOUT, I_HWIN, I_HLB, I_HNW, I_HWOUT, I_FG, I_FU, I_FD, I_RT, I_EG, I_EU, I_ED };

__device__ __forceinline__ void tr_item(const float* W, int ldw, int k0, int n0, bf16_t* WT, int ldt, int dst_row0, LAS float* scr, int lane) {
    float wv[32];
#pragma unroll
    for (int i = 0; i < 32; ++i) { const int kk = 2 * i + (lane >> 5); wv[i] = W[(size_t)(k0 + kk) * ldw + n0 + (lane & 31)]; }
#pragma unroll
    for (int i = 0; i < 32; ++i) { const int kk = 2 * i + (lane >> 5); scr[kk * 33 + (lane & 31)] = wv[i]; }
    asm volatile("s_waitcnt lgkmcnt(0)" ::: "memory");
    const int c = lane & 7;
#pragma unroll
    for (int j = 0; j < 4; ++j) { const int n = (lane >> 3) + 8 * j; const LAS float* s = scr + (8 * c) * 33 + n;
        u32x4 o; o.x = pk2(s[0 * 33], s[1 * 33]); o.y = pk2(s[2 * 33], s[3 * 33]); o.z = pk2(s[4 * 33], s[5 * 33]); o.w = pk2(s[6 * 33], s[7 * 33]);
        *(u32x4*)(WT + (size_t)(dst_row0 + n) * ldt + k0 + 8 * c) = o; }
    asm volatile("s_waitcnt lgkmcnt(0)" ::: "memory");
}
__device__ __forceinline__ void tr_matrix_item(const float* W, int K, int ldw, int ncols, bf16_t* WT, int mode, int item, LAS float* scr, int lane) {
    const int nblk = ncols / 32, kb = item / nblk, nb = item % nblk, n0 = nb * 32;
    const int dr = (mode == 0) ? n0 : (mode == 3) ? (n0 + (n0 < 1024 ? 0 : (n0 < 2048 ? 1024 : -1024))) : (mode == 4) ? (n0 + (n0 < 2048 ? 0 : (n0 < 3072 ? 1024 : -1024)))
                                     : ((n0 >> 7) * 256 + (n0 & 127) + (mode == 2 ? 128 : 0));
    tr_item(W, ldw, kb * 64, n0, WT, K, dr, scr, lane);
}
constexpr int CV_MIN = 16 * 96, CV_SQ = 16 * 32, CV_FG1 = 16 * 88, CV_FD1 = 44 * 32, CV_HIN = 16 * 128, CV_EG1 = 16 * 44, CV_ED1 = 22 * 32;
constexpr int CV_PER_LP = CV_MIN + CV_SQ + 2 * CV_FG1 + CV_FD1 + CV_HIN + CV_SQ + 8 * (2 * CV_EG1 + CV_ED1);
constexpr int CV_FIRST = CV_MIN + CV_SQ + 2 * CV_FG1 + CV_FD1;
constexpr int CV_TAIL1 = (CV_PER_LP * 2) / 5;
__device__ __forceinline__ void convert_items(LAS unsigned char* lds, int tid, int vb, int NV, int it_lo, int it_hi) {
    tid = opaque_v(tid); vb = opaque_s(vb);
    const int lane = tid & 63, wave = __builtin_amdgcn_readfirstlane(tid >> 6);
    unsigned char* ws = kws();
    LAS float* scr = (LAS float*)(lds + wave * 8448);
    constexpr int I_MIN = CV_MIN, I_SQ = CV_SQ, I_FG1 = CV_FG1, I_FD1 = CV_FD1, I_HIN = CV_HIN, I_EG1 = CV_EG1, I_ED1 = CV_ED1;
    constexpr int PER_LP = CV_PER_LP;
    const int gw = vb * 8 + wave, NGW = NV * 8;
    for (int it = it_lo + gw; it < it_hi; it += NGW) {
        const int j = it / PER_LP; int r = it % PER_LP;
        unsigned char* wb = ws + WS_WGT + (size_t)j * LP_BYTES;
        if (r < I_MIN) { tr_matrix_item(karg(I_MWIN) + (size_t)j * 1024 * MPROJ, 1024, MPROJ, MPROJ_G, (bf16_t*)(wb + W_MIN), 3, r, scr, lane); continue; } r -= I_MIN;
        if (r < I_SQ) { tr_matrix_item(karg(I_MWOUT) + (size_t)j * 1024 * 1024, 1024, 1024, 1024, (bf16_t*)(wb + W_MOUT), 0, r, scr, lane); continue; } r -= I_SQ;
        if (r < I_FG1) { tr_matrix_item(karg(I_FG) + (size_t)j * 1024 * DFF, 1024, DFF, DFF, (bf16_t*)(wb + W_FGU), 1, r, scr, lane); continue; } r -= I_FG1;
        if (r < I_FG1) { tr_matrix_item(karg(I_FU) + (size_t)j * 1024 * DFF, 1024, DFF, DFF, (bf16_t*)(wb + W_FGU), 2, r, scr, lane); continue; } r -= I_FG1;
        if (r < I_FD1) { tr_matrix_item(karg(I_FD) + (size_t)j * DFF * 1024, DFF, 1024, 1024, (bf16_t*)(wb + W_FD), 0, r, scr, lane); continue; } r -= I_FD1;
        if (r < I_HIN) { tr_matrix_item(karg(I_HWIN) + (size_t)j * 1024 * HPROJ, 1024, HPROJ, HPROJ, (bf16_t*)(wb + W_HIN), 4, r, scr, lane); continue; } r -= I_HIN;
        if (r < I_SQ) { tr_matrix_item(karg(I_HWOUT) + (size_t)j * 1024 * 1024, 1024, 1024, 1024, (bf16_t*)(wb + W_HOUT), 0, r, scr, lane); continue; } r -= I_SQ;
        const int e = r / (2 * I_EG1 + I_ED1); r -= e * (2 * I_EG1 + I_ED1);
        if (r < I_EG1) { tr_matrix_item(karg(I_EG) + ((size_t)j * 8 + e) * 1024 * DFE, 1024, DFE, DFE, (bf16_t*)(wb + W_EGU) + (size_t)e * 2816 * 1024, 1, r, scr, lane); continue; } r -= I_EG1;
        if (r < I_EG1) { tr_matrix_item(karg(I_EU) + ((size_t)j * 8 + e) * 1024 * DFE, 1024, DFE, DFE, (bf16_t*)(wb + W_EGU) + (size_t)e * 2816 * 1024, 2, r, scr, lane); continue; } r -= I_EG1;
        tr_matrix_item(karg(I_ED) + ((size_t)j * 8 + e) * DFE * 1024, DFE, 1024, 1024, (bf16_t*)(wb + W_ED) + (size_t)e * 1024 * DFE, 0, r, scr, lane);
    }
}

__device__ __forceinline__ void tail_convert(LAS unsigned char* lds, int tid, int c, int G, int nwg, int it_lo, int it_hi) {
    const int rounds = (nwg + G - 1) / G, n_last = nwg - G * (rounds - 1);
    if (n_last >= G || rounds == 0) convert_items(lds, tid, c, G, it_lo, it_hi);
    else if (c >= n_last) convert_items(lds, tid, c - n_last, G - n_last, it_lo, it_hi);
}
__device__ __forceinline__ void p0_phase(LAS unsigned char* lds, int tid, int bid, int G) {
    tid = opaque_v(tid); bid = opaque_s(bid);
    const int lane = tid & 63, wave = __builtin_amdgcn_readfirstlane(tid >> 6);
    unsigned char* ws = kws();
    LAS float* cond = (LAS float*)(lds + 69632);
    LAS float* red = (LAS float*)(lds + 102400);
    for (int i = tid; i < 8 * 1024; i += 512) cond[i] = siluf_(karg(I_C)[i]);
    __syncthreads();
    float* mod = (float*)(ws + WS_MOD);
    for (int item = bid; item < 256; item += G) {
        const int L = item >> 6, n0 = (item & 63) * 96;
        float acc[8][2];
#pragma unroll
        for (int b = 0; b < 8; ++b) { acc[b][0] = 0.f; acc[b][1] = 0.f; }
        if (lane < 48) {
            const float* wp = karg(I_ADAW) + ((size_t)L * 1024 + wave * 128) * 6144 + n0 + 2 * lane;
#pragma unroll 8
            for (int k = 0; k < 128; ++k) { const f32x2 wv = *(const f32x2*)(wp + (size_t)k * 6144);
#pragma unroll
                for (int b = 0; b < 8; ++b) { const float cv = cond[b * 1024 + wave * 128 + k]; acc[b][0] += cv * wv.x; acc[b][1] += cv * wv.y; } }
#pragma unroll
            for (int b = 0; b < 8; ++b) { red[(wave * 8 + b) * 96 + 2 * lane] = acc[b][0]; red[(wave * 8 + b) * 96 + 2 * lane + 1] = acc[b][1]; }
        }
        __syncthreads();
        for (int o = tid; o < 768; o += 512) { const int b = o / 96, n = o % 96; float s = 0.f;
#pragma unroll
            for (int w = 0; w < 8; ++w) s += red[(w * 8 + b) * 96 + n];
            mod[((size_t)L * 8 + b) * 6144 + n0 + n] = s + karg(I_ADAB)[L * 6144 + n0 + n]; }
        __syncthreads();
    }
    if (bid == 0) { float* lb = (float*)(ws + WS_LB); for (int d = tid; d < 1024; d += 512) lb[d] = sigmoidf_(karg(I_HLB)[1024 + d] - karg(I_HLB)[d]); }
    for (int i = bid * 512 + tid; i < 2 * 16 * 1024 + 2 * 8 * 1024; i += G * 512) {
        if (i < 2 * 16 * 1024) { const int j = i >> 14, g = (i >> 10) & 15, k = i & 1023;
            ((float*)(ws + WS_WGT + (size_t)j * LP_BYTES + W_MGATE))[g * 1024 + k] = karg(I_MWIN)[((size_t)j * 1024 + k) * MPROJ + MPROJ_G + g]; }
        else { const int i2 = i - 2 * 16 * 1024; const int j = i2 >> 13, e = (i2 >> 10) & 7, k = i2 & 1023;
            ((float*)(ws + WS_WGT + (size_t)j * LP_BYTES + W_ROUT))[e * 1024 + k] = karg(I_RT)[((size_t)j * 1024 + k) * 8 + e]; }
    }
    convert_items(lds, tid, bid, G, 0, CV_PER_LP);
}

template <int MODE, bool COMBINE, bool XF32 = false>
__device__ __forceinline__ void norm_phase(LAS unsigned char* lds, int tid, int bid, int G, const void* xsrc, bf16_t* xdst, const bf16_t* Y,
                                           const float* normw, const float* shift, const float* scale, bf16_t* hn,
                                           const float* Wx  , const float* ibias, const float* fbias, float* li, float* lf,
                                           unsigned* gcnt, int* lst_tok, float* lst_w) {
    tid = opaque_v(tid); bid = opaque_s(bid);
    const int lane = tid & 63, wave = __builtin_amdgcn_readfirstlane(tid >> 6);
    constexpr int NX = (MODE == 1) ? 16 : 8;
    LAS float* wl = (LAS float*)lds;
    LAS unsigned* lcnt = (LAS unsigned*)(lds + 65536);
    LAS unsigned* gbase = (LAS unsigned*)(lds + 65536 + 64);
    LAS int* rinfo = (LAS int*)(lds + 65536 + 128);
    if (MODE != 0) { for (int i = tid; i < NX * 1024; i += 512) { const int g = i >> 10, r = i & 1023, m = r >> 8, ln = (r >> 2) & 63, e = r & 3; wl[i] = Wx[g * 1024 + 8 * ln + 512 * (m >> 1) + 4 * (m & 1) + e]; } }
    __syncthreads();
    for (int blk = bid; blk < T / 128; blk += G) {
        const int b = blk >> 5;
        f32x4 gw[4], sh[4];
#pragma unroll
        for (int j = 0; j < 4; ++j) { const int col = 8 * lane + 512 * (j >> 1) + 4 * (j & 1); const f32x4 w = *(const f32x4*)(normw + col), sc = *(const f32x4*)(scale + (size_t)b * 6144 + col);
            gw[j] = w * (1.f + sc); sh[j] = *(const f32x4*)(shift + (size_t)b * 6144 + col); }
        if (MODE == 2) { if (tid < 8) lcnt[tid] = 0u; __syncthreads(); }
        f32x4 pxf[4]; u32x4 pxb[2], py0[2], py1[2];
#define NP_LOAD(rw) do { \
            if (XF32) { _Pragma("unroll") for (int j = 0; j < 4; ++j) pxf[j] = *(const f32x4*)((const float*)xsrc + (rw) * D + 8 * lane + 512 * (j >> 1) + 4 * (j & 1)); } \
            else { _Pragma("unroll") for (int jj = 0; jj < 2; ++jj) pxb[jj] = *(const u32x4*)((const bf16_t*)xsrc + (rw) * XP + 8 * lane + 512 * jj); } \
            if (COMBINE) { _Pragma("unroll") for (int jj = 0; jj < 2; ++jj) { py0[jj] = *(const u32x4*)(Y + ((rw) * 2) * D + 8 * lane + 512 * jj); py1[jj] = *(const u32x4*)(Y + ((rw) * 2 + 1) * D + 8 * lane + 512 * jj); } } } while (0)
        NP_LOAD((size_t)blk * 128 + wave * 16);
        f32x4 vp[4];
        for (int i = 0; i < 16; ++i) {
            const int rl = wave * 16 + i; const size_t row = (size_t)blk * 128 + rl;
            f32x4 v[4]; float s = 0.f; u32x4 cy0[2], cy1[2];
            if (XF32) {
#pragma unroll
                for (int j = 0; j < 4; ++j) v[j] = pxf[j];
            } else {
#pragma unroll
                for (int jj = 0; jj < 2; ++jj) { v[2 * jj] = (f32x4){bf2f_lo(pxb[jj].x), bf2f_hi(pxb[jj].x), bf2f_lo(pxb[jj].y), bf2f_hi(pxb[jj].y)}; v[2 * jj + 1] = (f32x4){bf2f_lo(pxb[jj].z), bf2f_hi(pxb[jj].z), bf2f_lo(pxb[jj].w), bf2f_hi(pxb[jj].w)}; }
            }
            if (COMBINE) {
#pragma unroll
                for (int jj = 0; jj < 2; ++jj) { cy0[jj] = py0[jj]; cy1[jj] = py1[jj]; }
            }
            { const size_t rn = (size_t)blk * 128 + wave * 16 + (i < 15 ? i + 1 : i); NP_LOAD(rn); }
            if (COMBINE) {
#pragma unroll
                for (int jj = 0; jj < 2; ++jj) { const u32x4 y0 = cy0[jj], y1 = cy1[jj];
                    v[2 * jj].x += bf2f_lo(y0.x) + bf2f_lo(y1.x); v[2 * jj].y += bf2f_hi(y0.x) + bf2f_hi(y1.x); v[2 * jj].z += bf2f_lo(y0.y) + bf2f_lo(y1.y); v[2 * jj].w += bf2f_hi(y0.y) + bf2f_hi(y1.y);
                    v[2 * jj + 1].x += bf2f_lo(y0.z) + bf2f_lo(y1.z); v[2 * jj + 1].y += bf2f_hi(y0.z) + bf2f_hi(y1.z); v[2 * jj + 1].z += bf2f_lo(y0.w) + bf2f_lo(y1.w); v[2 * jj + 1].w += bf2f_hi(y0.w) + bf2f_hi(y1.w);
                    u32x4 xo4; xo4.x = pk2(v[2 * jj].x, v[2 * jj].y); xo4.y = pk2(v[2 * jj].z, v[2 * jj].w); xo4.z = pk2(v[2 * jj + 1].x, v[2 * jj + 1].y); xo4.w = pk2(v[2 * jj + 1].z, v[2 * jj + 1].w);
                    *(u32x4*)(xdst + row * XP + 8 * lane + 512 * jj) = xo4; }
            }
#pragma unroll
            for (int j = 0; j < 4; ++j) s += (v[j].x * v[j].x + v[j].y * v[j].y) + (v[j].z * v[j].z + v[j].w * v[j].w);
            const float rstd = rsqrtf(wave_sum(s) * (1.f / D) + EPS);
#pragma unroll
            for (int j = 0; j < 4; ++j) v[j] = v[j] * rstd * gw[j] + sh[j];
#pragma unroll
            for (int jj = 0; jj < 2; ++jj) { u32x4 o; o.x = pk2(v[2 * jj].x, v[2 * jj].y); o.y = pk2(v[2 * jj].z, v[2 * jj].w); o.z = pk2(v[2 * jj + 1].x, v[2 * jj + 1].y); o.w = pk2(v[2 * jj + 1].z, v[2 * jj + 1].w);
                *(u32x4*)(hn + row * D + 8 * lane + 512 * jj) = o; }
            if (MODE != 0) {
                if ((i & 1) == 0) {
#pragma unroll
                    for (int j = 0; j < 4; ++j) vp[j] = v[j];
                } else {
                    float pa[NX], pb[NX];
#pragma unroll
                    for (int g = 0; g < NX; ++g) { f32x2 a0 = (f32x2){0.f, 0.f}, a1 = a0;
#pragma unroll
                        for (int j = 0; j < 4; ++j) { const f32x4 w = *(const LAS f32x4*)(wl + g * 1024 + 4 * lane + 256 * j); const f32x2 wlo = (f32x2){w.x, w.y}, whi = (f32x2){w.z, w.w};
                            a0 = a0 + (f32x2){vp[j].x, vp[j].y} * wlo; a0 = a0 + (f32x2){vp[j].z, vp[j].w} * whi;
                            a1 = a1 + (f32x2){v[j].x, v[j].y} * wlo; a1 = a1 + (f32x2){v[j].z, v[j].w} * whi; }
                        pa[g] = a0.x + a0.y; pb[g] = a1.x + a1.y; }
                    const bool b5 = (lane & 32) != 0, b4 = (lane & 16) != 0, b3 = (lane & 8) != 0, b2 = (lane & 4) != 0;
                    float ra, rb;
                    if (NX == 16) {
                        float qa[8], qb[8];
#pragma unroll
                        for (int k = 0; k < 8; ++k) { qa[k] = (b5 ? pa[8 + k] : pa[k]) + __shfl_xor(b5 ? pa[k] : pa[8 + k], 32); qb[k] = (b5 ? pb[8 + k] : pb[k]) + __shfl_xor(b5 ? pb[k] : pb[8 + k], 32); }
                        float ta[4], tb[4];
#pragma unroll
                        for (int k = 0; k < 4; ++k) { ta[k] = (b4 ? qa[4 + k] : qa[k]) + __shfl_xor(b4 ? qa[k] : qa[4 + k], 16); tb[k] = (b4 ? qb[4 + k] : qb[k]) + __shfl_xor(b4 ? qb[k] : qb[4 + k], 16); }
                        float ua[2], ub[2];
#pragma unroll
                        for (int k = 0; k < 2; ++k) { ua[k] = (b3 ? ta[2 + k] : ta[k]) + __shfl_xor(b3 ? ta[k] : ta[2 + k], 8); ub[k] = (b3 ? tb[2 + k] : tb[k]) + __shfl_xor(b3 ? tb[k] : tb[2 + k], 8); }
                        ra = (b2 ? ua[1] : ua[0]) + __shfl_xor(b2 ? ua[0] : ua[1], 4); rb = (b2 ? ub[1] : ub[0]) + __shfl_xor(b2 ? ub[0] : ub[1], 4);
                        ra += __shfl_xor(ra, 2); rb += __shfl_xor(rb, 2); ra += __shfl_xor(ra, 1); rb += __shfl_xor(rb, 1);
                    } else {
                        float ta[4], tb[4];
#pragma unroll
                        for (int k = 0; k < 4; ++k) { ta[k] = (b5 ? pa[4 + k] : pa[k]) + __shfl_xor(b5 ? pa[k] : pa[4 + k], 32); tb[k] = (b5 ? pb[4 + k] : pb[k]) + __shfl_xor(b5 ? pb[k] : pb[4 + k], 32); }
                        float ua[2], ub[2];
#pragma unroll
                        for (int k = 0; k < 2; ++k) { ua[k] = (b4 ? ta[2 + k] : ta[k]) + __shfl_xor(b4 ? ta[k] : ta[2 + k], 16); ub[k] = (b4 ? tb[2 + k] : tb[k]) + __shfl_xor(b4 ? tb[k] : tb[2 + k], 16); }
                        ra = (b3 ? ua[1] : ua[0]) + __shfl_xor(b3 ? ua[0] : ua[1], 8); rb = (b3 ? ub[1] : ub[0]) + __shfl_xor(b3 ? ub[0] : ub[1], 8);
                        ra += __shfl_xor(ra, 4); rb += __shfl_xor(rb, 4); ra += __shfl_xor(ra, 2); rb += __shfl_xor(rb, 2); ra += __shfl_xor(ra, 1); rb += __shfl_xor(rb, 1);
                    }
                    if (MODE == 1) {
                        if ((lane & 3) == 0) { const int g = lane >> 2;
#pragma unroll
                            for (int q = 0; q < 2; ++q) { const size_t rw = row - 1 + q; const float sum = q ? rb : ra;
                                if (g < 8) { const float a = sum + ibias[g]; li[rw * 8 + g] = 15.f * tanhf(a * (1.f / 15.f)); }
                                else { const float a = sum + fbias[g - 8]; lf[rw * 8 + g - 8] = fminf(a, 0.f) - log1pf(expf(-fabsf(a))); } } }
                    }
                    if (MODE == 2) {
#pragma unroll
                        for (int q = 0; q < 2; ++q) { const float rr = q ? rb : ra;
                            float lg[8];
#pragma unroll
                            for (int e = 0; e < 8; ++e) lg[e] = __builtin_bit_cast(float, __builtin_amdgcn_readlane(__builtin_bit_cast(int, rr), 8 * e));
                            int e0 = 0; float m0 = lg[0];
#pragma unroll
                            for (int e = 1; e < 8; ++e) if (lg[e] > m0) { m0 = lg[e]; e0 = e; }
                            int e1 = -1; float m1 = -3.0e38f;
#pragma unroll
                            for (int e = 0; e < 8; ++e) if (e != e0 && lg[e] > m1) { m1 = lg[e]; e1 = e; }
                            if (lane == 0) { const float w0 = 1.f / (1.f + __expf(m1 - m0)), w1 = 1.f - w0;
                                const unsigned p0 = __hip_atomic_fetch_add(lcnt + e0, 1u, __ATOMIC_RELAXED, __HIP_MEMORY_SCOPE_WORKGROUP), p1 = __hip_atomic_fetch_add(lcnt + e1, 1u, __ATOMIC_RELAXED, __HIP_MEMORY_SCOPE_WORKGROUP);
                                LAS int* ri = rinfo + (rl - 1 + q) * 6; ri[0] = e0; ri[1] = (int)p0; ri[2] = __builtin_bit_cast(int, w0); ri[3] = e1; ri[4] = (int)p1; ri[5] = __builtin_bit_cast(int, w1); } }
                    }
                }
            }
        }
        if (MODE == 2) {
            __syncthreads();
            if (tid < 8) gbase[tid] = __hip_atomic_fetch_add(gcnt + tid, lcnt[tid], __ATOMIC_RELAXED, __HIP_MEMORY_SCOPE_AGENT);
            __syncthreads();
            if (tid < 128) { const LAS int* ri = rinfo + tid * 6; const int tok = blk * 128 + tid;
                const int e0 = ri[0], e1 = ri[3]; const size_t q0 = (size_t)e0 * T + gbase[e0] + ri[1], q1 = (size_t)e1 * T + gbase[e1] + ri[4];
                lst_tok[q0] = tok * 2; lst_w[q0] = __builtin_bit_cast(float, ri[2]); lst_tok[q1] = tok * 2 + 1; lst_w[q1] = __builtin_bit_cast(float, ri[5]); }
            __syncthreads();
        }
    }
}
#undef NP_LOAD
template <bool COMBINE>
__device__ __forceinline__ void final_phase(int tid, int bid, int G, float* x, const bf16_t* Y, const float* fw) {
    tid = opaque_v(tid); bid = opaque_s(bid);
    const int lane = tid & 63, wave = tid >> 6;
    f32x4 w4[4];
#pragma unroll
    for (int j = 0; j < 4; ++j) w4[j] = *(const f32x4*)(fw + 8 * lane + 512 * (j >> 1) + 4 * (j & 1));
    u32x4 pxb[2], py0[2], py1[2];
#define FP_LOAD(rw) do { _Pragma("unroll") for (int jj = 0; jj < 2; ++jj) { pxb[jj] = *(const u32x4*)((const bf16_t*)x + (rw) * XP + 8 * lane + 512 * jj); \
        if (COMBINE) { py0[jj] = *(const u32x4*)(Y + ((rw) * 2) * D + 8 * lane + 512 * jj); py1[jj] = *(const u32x4*)(Y + ((rw) * 2 + 1) * D + 8 * lane + 512 * jj); } } } while (0)
    { const size_t r0 = (size_t)bid * 8 + wave; FP_LOAD((r0 < (size_t)T ? r0 : (size_t)0)); }
    for (size_t row = (size_t)bid * 8 + wave; row < (size_t)T; row += (size_t)G * 8) {
        f32x4 v[4]; float s = 0.f; u32x4 cy0[2], cy1[2];
#pragma unroll
        for (int jj = 0; jj < 2; ++jj) { v[2 * jj] = (f32x4){bf2f_lo(pxb[jj].x), bf2f_hi(pxb[jj].x), bf2f_lo(pxb[jj].y), bf2f_hi(pxb[jj].y)}; v[2 * jj + 1] = (f32x4){bf2f_lo(pxb[jj].z), bf2f_hi(pxb[jj].z), bf2f_lo(pxb[jj].w), bf2f_hi(pxb[jj].w)};
            if (COMBINE) { cy0[jj] = py0[jj]; cy1[jj] = py1[jj]; } }
        { const size_t rn = row + (size_t)G * 8; FP_LOAD((rn < (size_t)T ? rn : row)); }
        if (COMBINE) {
#pragma unroll
            for (int jj = 0; jj < 2; ++jj) { const u32x4 y0 = cy0[jj], y1 = cy1[jj];
                v[2 * jj].x += bf2f_lo(y0.x) + bf2f_lo(y1.x); v[2 * jj].y += bf2f_hi(y0.x) + bf2f_hi(y1.x); v[2 * jj].z += bf2f_lo(y0.y) + bf2f_lo(y1.y); v[2 * jj].w += bf2f_hi(y0.y) + bf2f_hi(y1.y);
                v[2 * jj + 1].x += bf2f_lo(y0.z) + bf2f_lo(y1.z); v[2 * jj + 1].y += bf2f_hi(y0.z) + bf2f_hi(y1.z); v[2 * jj + 1].z += bf2f_lo(y0.w) + bf2f_lo(y1.w); v[2 * jj + 1].w += bf2f_hi(y0.w) + bf2f_hi(y1.w); }
        }
#pragma unroll
        for (int j = 0; j < 4; ++j) s += (v[j].x * v[j].x + v[j].y * v[j].y) + (v[j].z * v[j].z + v[j].w * v[j].w);
        const float rstd = rsqrtf(wave_sum(s) * (1.f / D) + EPS);
#pragma unroll
        for (int j = 0; j < 4; ++j) *(f32x4*)(x + row * D + 8 * lane + 512 * (j >> 1) + 4 * (j & 1)) = v[j] * rstd * w4[j];
    }
#undef FP_LOAD
}

#define MK_DPP_F(idv, v, ctrl, rmask) __builtin_bit_cast(float, __builtin_amdgcn_update_dpp(__builtin_bit_cast(int, (float)(idv)), __builtin_bit_cast(int, (float)(v)), (ctrl), (rmask), 0xf, false))
__device__ __forceinline__ float wave_scan_add(float v) {
    v += MK_DPP_F(0.f, v, 0x111, 0xf); v += MK_DPP_F(0.f, v, 0x112, 0xf); v += MK_DPP_F(0.f, v, 0x114, 0xf); v += MK_DPP_F(0.f, v, 0x118, 0xf);
    v += MK_DPP_F(0.f, v, 0x142, 0xa); v += MK_DPP_F(0.f, v, 0x143, 0xc);
    return v;
}
__device__ __forceinline__ float wave_scan_max(float v) {
    constexpr float NI = -3.0e38f;
    v = fmaxf(v, MK_DPP_F(NI, v, 0x111, 0xf)); v = fmaxf(v, MK_DPP_F(NI, v, 0x112, 0xf)); v = fmaxf(v, MK_DPP_F(NI, v, 0x114, 0xf)); v = fmaxf(v, MK_DPP_F(NI, v, 0x118, 0xf));
    v = fmaxf(v, MK_DPP_F(NI, v, 0x142, 0xa)); v = fmaxf(v, MK_DPP_F(NI, v, 0x143, 0xc));
    return v;
}
struct MpPf { u32x4 pq, pk, phq, phk; f32x4 pg4; };
__device__ __forceinline__ void mp_load(MpPf& P, int itx, int tid, int lane, const bf16_t* QKR, const bf16_t* OGT, const bf16_t* VTT, const float* LIb, const float* LFb) {
    const int b_ = itx >> 9, h_ = (itx >> 6) & 7, c_ = itx & 63; const size_t m0_ = (size_t)b_ * SEQ + (size_t)c_ * 64; const size_t ib_ = (size_t)itx * 8192 + tid * 8;
    P.pq = *(const u32x4*)(QKR + ib_); P.pk = *(const u32x4*)(QKR + ib_ + 4096);
    { const size_t hb_ = (itx > 0 ? ib_ - 8192 : ib_) + (size_t)(tid < 24 ? 61 * 64 : 0); P.phq = *(const u32x4*)(QKR + hb_); P.phk = *(const u32x4*)(QKR + hb_ + 4096);
      if (c_ == 0) { P.phq = (u32x4){0u, 0u, 0u, 0u}; P.phk = P.phq; } }
    { const float* gp_ = (tid < 64) ? LIb : LFb; P.pg4 = *(const f32x4*)(gp_ + (m0_ + (tid & 63)) * 8 + 4 * (h_ >> 2)); }
}
__device__ __forceinline__ void mlstm_prep(LAS unsigned char* lds, int tid, int bid, int G, const bf16_t* QKR, bf16_t* OGT, const bf16_t* VTT, const float* LIb, const float* LFb, f32x4* SCT, f32x4* SCI,
                                           const float* convw, const float* convb, const float* normw, bf16_t* QKT, bf16_t* U) {
    tid = opaque_v(tid); bid = opaque_s(bid);
    const int lane = tid & 63, w = __builtin_amdgcn_readfirstlane(tid >> 6), l15 = lane & 15, q4 = lane >> 4;
    LAS bf16_t* QR = (LAS bf16_t*)(lds + 0);
    LAS bf16_t* KR = (LAS bf16_t*)(lds + 8704);
    LAS bf16_t* Qc = (LAS bf16_t*)(lds + 17408);
    LAS bf16_t* Kc = (LAS bf16_t*)(lds + 26624);
    LAS bf16_t* KT = (LAS bf16_t*)(lds + 35840);
    LAS bf16_t* VT = (LAS bf16_t*)(lds + 45056);
    LAS bf16_t* Sm = (LAS bf16_t*)(lds + 63488);
    LAS float* fs = (LAS float*)(lds + 72704);
    LAS float *liv = fs, *lfv = fs + 64, *av = fs + 128, *pmx = fs + 192, *rsp = fs + 256  , *knp = fs + 384  , *bcs = fs + 896  ;
    const int pr = tid >> 3, pp = tid & 7;
    LAS float* cvt = (LAS float*)(lds + 76544);
    for (int i = tid; i < 8 * 640; i += 512) { const int h_ = i / 640, r_ = i % 640; cvt[i] = (r_ < 512) ? convw[((r_ >> 6) & 3) * 1024 + (r_ >> 8) * 512 + h_ * 64 + (r_ & 63)] : convb[((r_ - 512) >> 6) * 512 + h_ * 64 + (r_ & 63)]; }
    __syncthreads();
    MpPf PA, PB;
    if (bid < 4096) { mp_load(PA, bid, tid, lane, QKR, OGT, VTT, LIb, LFb); mp_load(PB, (bid + G < 4096) ? bid + G : bid, tid, lane, QKR, OGT, VTT, LIb, LFb); }
#define MP_STEP(P, it) do { \
        const int b = it >> 9, h = (it >> 6) & 7, c = it & 63; const size_t m0 = (size_t)b * SEQ + (size_t)c * 64; \
        *(LAS u32x4*)(QR + (3 + pr) * 64 + 8 * pp) = P.pq; *(LAS u32x4*)(KR + (3 + pr) * 64 + 8 * pp) = P.pk; \
        if (tid < 24) { *(LAS u32x4*)(QR + pr * 64 + 8 * pp) = P.phq; *(LAS u32x4*)(KR + pr * 64 + 8 * pp) = P.phk; } \
        { const float pgv = ((h & 3) == 0) ? P.pg4[0] : ((h & 3) == 1) ? P.pg4[1] : ((h & 3) == 2) ? P.pg4[2] : P.pg4[3]; if (tid < 64) liv[tid] = pgv; else if (tid < 128) lfv[tid - 64] = pgv; } \
        float wq[4], wk4[4]; const float bq = cvt[h * 640 + 512 + lane], bk = cvt[h * 640 + 576 + lane]; \
        _Pragma("unroll") \
        for (int j = 0; j < 4; ++j) { wq[j] = cvt[h * 640 + j * 64 + lane]; wk4[j] = cvt[h * 640 + 256 + j * 64 + lane]; } \
        __syncthreads(); \
        { const int itn_ = (it + 2 * G < 4096) ? it + 2 * G : it; mp_load(P, itn_, tid, lane, QKR, OGT, VTT, LIb, LFb); } \
        if (w == 0) { \
            const float bsum = wave_scan_add(lfv[lane]); \
            const float a = liv[lane] - bsum; const float pm = wave_scan_max(a); \
            av[lane] = a; pmx[lane] = pm; bcs[lane] = bsum; \
        } \
        float kk8[8]; \
        { float xq[11], xk[11]; \
        _Pragma("unroll") \
          for (int r = 0; r < 11; ++r) { xq[r] = bf2f(QR[(8 * w + r) * 64 + lane]); xk[r] = bf2f(KR[(8 * w + r) * 64 + lane]); } \
        _Pragma("unroll") \
          for (int e = 0; e < 8; ++e) { float aq = bq, ak = bk; \
        _Pragma("unroll") \
              for (int j = 0; j < 4; ++j) { aq += wq[j] * xq[e + j]; ak += wk4[j] * xk[e + j]; } \
              aq = siluf_(aq); kk8[e] = siluf_(ak) * 0.125f; \
              Qc[(8 * w + e) * 72 + lane] = (bf16_t)f2bf(aq); Kc[(8 * w + e) * 72 + lane] = (bf16_t)f2bf(kk8[e]); } } \
        __syncthreads(); \
        { const float pm63 = pmx[63]; float ksum = 0.f; float kt[8]; \
        _Pragma("unroll") \
          for (int e = 0; e < 8; ++e) { kt[e] = kk8[e] * __expf(av[8 * w + e] - pm63); ksum += kt[e]; } \
          u32x4 o; o.x = pk2(kt[0], kt[1]); o.y = pk2(kt[2], kt[3]); o.z = pk2(kt[4], kt[5]); o.w = pk2(kt[6], kt[7]); \
          *(LAS u32x4*)(KT + lane * 72 + 8 * w) = o; knp[w * 64 + lane] = ksum; } \
        { const int ti = w >> 1; float psum = 0.f; \
        _Pragma("unroll") \
          for (int jj = 0; jj < 2; ++jj) { const int tj = 2 * (w & 1) + jj; const int t = 16 * ti + l15; \
              if (tj > ti) { *(LAS u32x2*)(Sm + t * 72 + 16 * tj + 4 * q4) = (u32x2){0u, 0u}; } \
              else { f32x4 acc = (f32x4){0.f, 0.f, 0.f, 0.f}; \
        _Pragma("unroll") \
                  for (int kk = 0; kk < 2; ++kk) { const bf16x8 a = *(const LAS bf16x8*)(Kc + (16 * tj + l15) * 72 + 32 * kk + 8 * q4), bq8 = *(const LAS bf16x8*)(Qc + (16 * ti + l15) * 72 + 32 * kk + 8 * q4); \
                      acc = MFMA16(a, bq8, acc); } \
                  const float pt = pmx[t]; const f32x4 a4 = *(const LAS f32x4*)(av + 16 * tj + 4 * q4); float vv[4]; float p = 0.f; \
        _Pragma("unroll") \
                  for (int r = 0; r < 4; ++r) { const int s = 16 * tj + 4 * q4 + r; vv[r] = (s <= t) ? acc[r] * __expf(a4[r] - pt) : 0.f; p += vv[r]; } \
                  u32x2 o; o.x = pk2(vv[0], vv[1]); o.y = pk2(vv[2], vv[3]); *(LAS u32x2*)(Sm + t * 72 + 16 * tj + 4 * q4) = o; \
                  psum += p; } } \
          psum += __shfl_xor(psum, 16); psum += __shfl_xor(psum, 32); \
          if (lane < 16) rsp[(w & 1) * 64 + 16 * ti + lane] = psum; } \
        __syncthreads(); \
        *(u32x4*)(U + (size_t)it * 4096 + tid * 8) = *(const LAS u32x4*)(Sm + pr * 72 + 8 * pp); \
        if (tid < 64) { SCT[(size_t)it * 64 + tid] = (f32x4){bcs[tid], pmx[tid], rsp[tid] + rsp[64 + tid], 0.f}; \
            const float kn = ((knp[tid] + knp[64 + tid]) + (knp[128 + tid] + knp[192 + tid])) + ((knp[256 + tid] + knp[320 + tid]) + (knp[384 + tid] + knp[448 + tid])); \
            SCI[(size_t)it * 64 + tid] = (f32x4){kn, pmx[63], bcs[63], 0.f}; } \
        *(u32x4*)(QKT + (size_t)it * 8192 + tid * 8) = *(const LAS u32x4*)(Qc + pr * 72 + 8 * pp); \
        *(u32x4*)(QKT + (size_t)it * 8192 + 4096 + tid * 8) = *(const LAS u32x4*)(KT + pr * 72 + 8 * pp); \
    } while (0)
    for (int it0 = bid; it0 < 4096; it0 += 2 * G) { MP_STEP(PA, it0); if (it0 + G < 4096) MP_STEP(PB, (it0 + G)); }
#undef MP_STEP
}

struct MsPf { u32x4 pq, pk, pv0, pv1, psm; u32x2 po; f32x4 pst, psi; };
__device__ __forceinline__ void ms_load(MsPf& P, int it_, int qd, int tid, int lane, int w, int l15, int q4, const bf16_t* OGT, const bf16_t* VTT, const f32x4* SCT, const f32x4* SCI, const bf16_t* QKT, const bf16_t* U) {
    const size_t ib = (size_t)it_ * 8192 + tid * 8;
    P.pq = *(const u32x4*)(QKT + (size_t)it_ * 8192 + (16 * qd) * 64 + (tid & 127) * 8);
    P.pk = *(const u32x4*)(QKT + ib + 4096); P.pv0 = *(const u32x4*)(VTT + ib); P.pv1 = *(const u32x4*)(VTT + ib + 4096);
    P.psm = *(const u32x4*)(U + (size_t)it_ * 4096 + (16 * qd) * 64 + (tid & 127) * 8);
    P.po = *(const u32x2*)(OGT + (size_t)it_ * 8192 + (16 * qd + l15) * 128 + 16 * w + 4 * q4);
    P.pst = SCT[(size_t)it_ * 64 + 16 * qd + l15]; P.psi = SCI[(size_t)it_ * 64 + lane];
}
__device__ __forceinline__ void mlstm_scan(LAS unsigned char* lds, int tid, int bid, int G, const bf16_t* OGT, const bf16_t* VTT, const f32x4* SCT, const f32x4* SCI,
                                           const bf16_t* QKT, const bf16_t* U, bf16_t* hh) {
    tid = opaque_v(tid); bid = opaque_s(bid);
    const int lane = tid & 63, w = __builtin_amdgcn_readfirstlane(tid >> 6), l15 = lane & 15, q4 = lane >> 4;
    LAS bf16_t* Qc = (LAS bf16_t*)(lds + 0);
    LAS bf16_t* KT = (LAS bf16_t*)(lds + 9216);
    LAS bf16_t* VT = (LAS bf16_t*)(lds + 18432);
    LAS bf16_t* CT = (LAS bf16_t*)(lds + 36864);
    LAS float* ssqp = (LAS float*)(lds + 57600);
    LAS bf16_t* Sq = (LAS bf16_t*)(lds + 58368);
    const int pr = tid >> 3, pp = tid & 7;
    for (int v = bid; v < 256; v += G) {
        const int qd = (v >> 3) & 3, unit = (v & 7) + 8 * (v >> 5);
        const int b = unit >> 3, h = unit & 7; const size_t mb = (size_t)b * SEQ; const int item0 = unit * 64;
        __syncthreads();
        for (int i = tid; i < 144 * 72 / 2; i += 512) ((LAS unsigned*)CT)[i] = 0u;
        f32x4 Cacc[4];
#pragma unroll
        for (int i = 0; i < 4; ++i) Cacc[i] = (f32x4){0.f, 0.f, 0.f, 0.f};
        float m_st = 0.f, nst = 0.f;
        MsPf PA, PB;
        ms_load(PA, item0, qd, tid, lane, w, l15, q4, OGT, VTT, SCT, SCI, QKT, U);
        ms_load(PB, item0 + 1, qd, tid, lane, w, l15, q4, OGT, VTT, SCT, SCI, QKT, U);
#define MS_STEP(P, cc) do { const size_t m0 = mb + (size_t)(cc) * 64 + 16 * qd; \
            if (tid < 128) { *(LAS u32x4*)(Qc + pr * 72 + 8 * pp) = P.pq; *(LAS u32x4*)(Sq + pr * 72 + 8 * pp) = P.psm; } \
            *(LAS u32x4*)(KT + pr * 72 + 8 * pp) = P.pk; *(LAS u32x4*)(VT + pr * 72 + 8 * pp) = P.pv0; *(LAS u32x4*)(VT + (64 + pr) * 72 + 8 * pp) = P.pv1; \
            const u32x2 og = P.po; const float bt = P.pst[0], pmt = P.pst[1], rst = P.pst[2], knv = P.psi[0], pm63 = P.psi[1], b63 = P.psi[2]; \
            __syncthreads(); \
            { const int cn = ((cc) + 2 < 64) ? (cc) + 2 : 63; ms_load(P, item0 + cn, qd, tid, lane, w, l15, q4, OGT, VTT, SCT, SCI, QKT, U); } \
            bf16x8 cf[2], cnf[2], vf[2], qf[2], smf[2], kf[4][2]; \
            _Pragma("unroll") for (int kk = 0; kk < 2; ++kk) { cf[kk] = *(const LAS bf16x8*)(CT + (16 * w + l15) * 72 + 32 * kk + 8 * q4); cnf[kk] = *(const LAS bf16x8*)(CT + (128 + l15) * 72 + 32 * kk + 8 * q4); \
                vf[kk] = *(const LAS bf16x8*)(VT + (16 * w + l15) * 72 + 32 * kk + 8 * q4); qf[kk] = *(const LAS bf16x8*)(Qc + l15 * 72 + 32 * kk + 8 * q4); smf[kk] = *(const LAS bf16x8*)(Sq + l15 * 72 + 32 * kk + 8 * q4); \
                _Pragma("unroll") for (int ti = 0; ti < 4; ++ti) kf[ti][kk] = *(const LAS bf16x8*)(KT + (16 * ti + l15) * 72 + 32 * kk + 8 * q4); } \
            f32x4 acc = (f32x4){0.f, 0.f, 0.f, 0.f}, accn = acc, u4 = acc, tmp[4]; \
            _Pragma("unroll") for (int kk = 0; kk < 2; ++kk) { acc = MFMA16(cf[kk], qf[kk], acc); accn = MFMA16(cnf[kk], qf[kk], accn); u4 = MFMA16(vf[kk], smf[kk], u4); } \
            _Pragma("unroll") for (int ti = 0; ti < 4; ++ti) { tmp[ti] = (f32x4){0.f, 0.f, 0.f, 0.f}; \
                _Pragma("unroll") for (int kk = 0; kk < 2; ++kk) tmp[ti] = MFMA16(kf[ti][kk], vf[kk], tmp[ti]); } \
            const float M63 = fmaxf(m_st, pm63), decay = __expf(m_st - M63), rho = __expf(pm63 - M63); \
            const float qn = accn[0]; \
            const float Mt = fmaxf(m_st, pmt), wt = __expf(m_st - Mt), rt = __expf(pmt - Mt); \
            const float den = wt * qn + rt * rst; const float dd = fmaxf(fabsf(den), __expf(-(bt + Mt))); \
            const f32x4 hv = (acc * wt + u4 * rt) * __builtin_amdgcn_rcpf(dd); \
            { const float p = rows4_sum((hv[0] * hv[0] + hv[1] * hv[1]) + (hv[2] * hv[2] + hv[3] * hv[3])); if (lane < 16) ssqp[lane * 8 + w] = p; } \
            _Pragma("unroll") for (int ti = 0; ti < 4; ++ti) Cacc[ti] = Cacc[ti] * decay + tmp[ti] * rho; \
            nst = nst * decay + knv * rho; \
            m_st = b63 + M63; \
            __syncthreads(); \
            _Pragma("unroll") for (int ti = 0; ti < 4; ++ti) { u32x2 o; o.x = pk2(Cacc[ti][0], Cacc[ti][1]); o.y = pk2(Cacc[ti][2], Cacc[ti][3]); *(LAS u32x2*)(CT + (16 * w + l15) * 72 + 16 * ti + 4 * q4) = o; } \
            if (w < 4) CT[(128 + 4 * w) * 72 + lane] = (bf16_t)f2bf(nst); \
            { const f32x4 s0 = *(const LAS f32x4*)(ssqp + l15 * 8), s1 = *(const LAS f32x4*)(ssqp + l15 * 8 + 4); \
              const float ssum = ((s0[0] + s0[1]) + (s0[2] + s0[3])) + ((s1[0] + s1[1]) + (s1[2] + s1[3])); \
              const float rstd = rsqrtf(ssum * (1.f / 128.f) + EPS); \
              u32x2 o; o.x = pk2(hv[0] * rstd * bf2f_lo(og.x), hv[1] * rstd * bf2f_hi(og.x)); o.y = pk2(hv[2] * rstd * bf2f_lo(og.y), hv[3] * rstd * bf2f_hi(og.y)); \
              *(u32x2*)(hh + (m0 + l15) * D + h * 128 + 16 * w + 4 * q4) = o; } \
        } while (0)
        for (int c = 0; c < 64; c += 2) { MS_STEP(PA, c); MS_STEP(PB, c + 1); }
#undef MS_STEP
    }
}

__device__ __forceinline__ int sw128(int r, int c) { return r * 136 + c; }
__device__ __forceinline__ int sw64(int r, int c) { return r * 72 + c; }
__device__ __forceinline__ void hgrn_prep(LAS unsigned char* lds, int tid, int bid, int G, bf16_t* QF, const bf16_t* VTT, bf16_t* OL, float* PFg) {
    tid = opaque_v(tid); bid = opaque_s(bid);
    const int lane = tid & 63, w = __builtin_amdgcn_readfirstlane(tid >> 6), l15 = lane & 15, q4 = lane >> 4;
    LAS bf16_t* QT = (LAS bf16_t*)(lds + 0);
    LAS bf16_t* KB = (LAS bf16_t*)(lds + 17408);
    LAS bf16_t* KH = (LAS bf16_t*)(lds + 34816);
    LAS bf16_t* QB = (LAS bf16_t*)(lds + 47872);
    LAS bf16_t* QH = (LAS bf16_t*)(lds + 65280);
    LAS bf16_t* KS = (LAS bf16_t*)(lds + 78336);
    LAS bf16_t* VT = (LAS bf16_t*)(lds + 96768);
    LAS bf16_t* AM = (LAS bf16_t*)(lds + 115200);
    LAS float* Fv = (LAS float*)(lds + 124416);
    const int d0 = 2 * (32 * (w & 1) + (lane & 31)), I = w >> 1, hf = lane >> 5, tb0 = 16 * I + 8 * hf;
    const int pr = tid >> 3, pp = tid & 7;
    unsigned pq2[8], pg2[8];
#define HP_PREFETCH(itx) do { const size_t qb_ = (size_t)(itx) * 16384 + (size_t)tb0 * 128 + d0; \
        _Pragma("unroll") for (int i = 0; i < 8; ++i) { pq2[i] = *(const unsigned*)(QF + qb_ + i * 128); pg2[i] = *(const unsigned*)(QF + qb_ + 8192 + i * 128); } \
        } while (0)
    if (bid < 4096) HP_PREFETCH(bid);
    for (int it = bid; it < 4096; it += G) {
        unsigned qtp[8], kbp[8];
        { float ca[8], cb[8], fa[8], fb[8]; float ea = 1.f, eb = 1.f;
#pragma unroll
          for (int i = 0; i < 8; ++i) { fa[i] = __expf(bf2f_lo(pg2[i])); fb[i] = __expf(bf2f_hi(pg2[i])); ea *= fa[i]; eb *= fb[i]; ca[i] = ea; cb[i] = eb; }
          const float ta = __shfl(ea, lane & 31), tb = __shfl(eb, lane & 31);
          const float pa = hf ? ta : 1.f, pb = hf ? tb : 1.f;
#pragma unroll
          for (int i = 0; i < 8; ++i) { const float e1a = ca[i] * pa, e1b = cb[i] * pb; const float ia = __builtin_amdgcn_rcpf(e1a), ib = __builtin_amdgcn_rcpf(e1b);
              qtp[i] = pk2(bf2f_lo(pq2[i]) * e1a, bf2f_hi(pq2[i]) * e1b); kbp[i] = pk2((1.f - fa[i]) * ia, (1.f - fb[i]) * ib);
              *(LAS unsigned*)(QT + sw128(tb0 + i, d0)) = qtp[i]; *(LAS unsigned*)(KB + sw128(tb0 + i, d0)) = kbp[i]; }
          if (hf) { Fv[I * 128 + d0] = ca[7] * pa; Fv[I * 128 + d0 + 1] = cb[7] * pb; } }
        __syncthreads();
        { const int itn_ = (it + G < 4096) ? it + G : it; HP_PREFETCH(itn_); }
        { const f32x2 F0 = *(const LAS f32x2*)(Fv + d0), F1 = *(const LAS f32x2*)(Fv + 128 + d0), F2 = *(const LAS f32x2*)(Fv + 256 + d0), F3 = *(const LAS f32x2*)(Fv + 384 + d0);
          const f32x2 one = (f32x2){1.f, 1.f};
          const f32x2 FI = (I == 0) ? F0 : (I == 1) ? F1 : (I == 2) ? F2 : F3;
          const f32x2 P = (I == 0) ? one : (I == 1) ? F0 : (I == 2) ? F0 * F1 : F0 * F1 * F2;
          const f32x2 suf = (I == 0) ? F1 * F2 * F3 : (I == 1) ? F2 * F3 : (I == 2) ? F3 : one;
          float ksa[8], ksb[8];
#pragma unroll
          for (int i = 0; i < 8; ++i) { const int t = tb0 + i; const float qa = bf2f_lo(qtp[i]), qb = bf2f_hi(qtp[i]); const float ka = bf2f_lo(kbp[i]) * FI.x, kb = bf2f_hi(kbp[i]) * FI.y;
              if (I < 3) *(LAS unsigned*)(KH + sw128(t, d0)) = pk2(ka, kb);
              *(LAS unsigned*)(QB + sw128(t, d0)) = pk2(qa * P.x, qb * P.y);
              ksa[i] = ka * suf.x; ksb[i] = kb * suf.y;
              if (I == 2) *(LAS unsigned*)(QH + sw128(8 * hf + i, d0)) = pk2(qa * F1.x, qb * F1.y);
              if (I == 3) { *(LAS unsigned*)(QH + sw128(16 + 8 * hf + i, d0)) = pk2(qa * F2.x, qb * F2.y);
                  *(LAS unsigned*)(QH + sw128(32 + 8 * hf + i, d0)) = pk2(qa * (F1.x * F2.x), qb * (F1.y * F2.y)); } }
          u32x4 oa, ob; oa.x = pk2(ksa[0], ksa[1]); oa.y = pk2(ksa[2], ksa[3]); oa.z = pk2(ksa[4], ksa[5]); oa.w = pk2(ksa[6], ksa[7]);
          ob.x = pk2(ksb[0], ksb[1]); ob.y = pk2(ksb[2], ksb[3]); ob.z = pk2(ksb[4], ksb[5]); ob.w = pk2(ksb[6], ksb[7]);
          *(LAS u32x4*)(KS + sw64(d0, tb0)) = oa; *(LAS u32x4*)(KS + sw64(d0 + 1, tb0)) = ob;
          if (I == 0 && hf == 0) { PFg[(size_t)it * 128 + d0] = (F0.x * F1.x) * (F2.x * F3.x); PFg[(size_t)it * 128 + d0 + 1] = (F0.y * F1.y) * (F2.y * F3.y); } }
        __syncthreads();
#pragma unroll
        for (int jj = 0; jj < 2; ++jj) { const int blk = 2 * w + jj, bi = blk >> 2, bj = blk & 3; const int t = 16 * bi + l15;
            if (bj > bi) { *(LAS u32x2*)(AM + sw64(t, 16 * bj + 4 * q4)) = (u32x2){0u, 0u}; }
            else { const LAS bf16_t* X; int xr; const LAS bf16_t* Yk = (bi == bj) ? KB : KH;
                if (bj + 1 >= bi) { X = QT; xr = 16 * bi; } else { X = QH; xr = (bi == 2) ? 0 : (bj == 1 ? 16 : 32); }
                f32x4 acc = (f32x4){0.f, 0.f, 0.f, 0.f};
#pragma unroll
                for (int kk = 0; kk < 4; ++kk) { const bf16x8 a = *(const LAS bf16x8*)(Yk + sw128(16 * bj + l15, 32 * kk + 8 * q4)), bq8 = *(const LAS bf16x8*)(X + sw128(xr + l15, 32 * kk + 8 * q4)); acc = MFMA16(a, bq8, acc); }
                float vv[4];
#pragma unroll
                for (int r = 0; r < 4; ++r) { const int s = 16 * bj + 4 * q4 + r; vv[r] = (s <= t) ? acc[r] : 0.f; }
                u32x2 o; o.x = pk2(vv[0], vv[1]); o.y = pk2(vv[2], vv[3]); *(LAS u32x2*)(AM + sw64(t, 16 * bj + 4 * q4)) = o; } }
        __syncthreads();
        *(u32x4*)(OL + (size_t)it * 4096 + tid * 8) = *(const LAS u32x4*)(AM + sw64(pr, 8 * pp));
#pragma unroll
        for (int j = 0; j < 2; ++j) { const int p = tid + 512 * j;
            *(u32x4*)(QF + (size_t)it * 16384 + p * 8) = *(const LAS u32x4*)(QB + sw128(p >> 4, 8 * (p & 15)));
            *(u32x4*)(QF + (size_t)it * 16384 + 8192 + p * 8) = *(const LAS u32x4*)(KS + sw64(p >> 3, 8 * (p & 7))); }
    }
#undef HP_PREFETCH
}

struct HsPf { u32x4 pqb, pks[2], pv0, pv1, pam; u32x2 pgt; f32x4 ppf; };
__device__ __forceinline__ void hs_load(HsPf& P, int it_, int qd, int tid, int lane, int w, int l15, int q4, const bf16_t* QF, const bf16_t* GT, const bf16_t* VTT, const bf16_t* OL, const float* PFg) {
    P.pqb = *(const u32x4*)(QF + (size_t)it_ * 16384 + (16 * qd) * 128 + (tid & 255) * 8);
#pragma unroll
    for (int j = 0; j < 2; ++j) P.pks[j] = *(const u32x4*)(QF + (size_t)it_ * 16384 + 8192 + (tid + 512 * j) * 8);
    P.pv0 = *(const u32x4*)(VTT + (size_t)it_ * 8192 + tid * 8); P.pv1 = *(const u32x4*)(VTT + (size_t)it_ * 8192 + 4096 + tid * 8);
    P.pam = *(const u32x4*)(OL + (size_t)it_ * 4096 + (16 * qd) * 64 + (tid & 127) * 8);
    P.pgt = *(const u32x2*)(GT + (size_t)it_ * 8192 + (16 * qd + l15) * 128 + 16 * w + 4 * q4);
    P.ppf = *(const f32x4*)(PFg + (size_t)it_ * 128 + 4 * (tid & 31));
}
__device__ __forceinline__ void hgrn_scan(LAS unsigned char* lds, int tid, int bid, int G, const bf16_t* QF, const bf16_t* GT, const bf16_t* VTT, const bf16_t* OL, const float* PFg, const float* normw, bf16_t* hh) {
    tid = opaque_v(tid); bid = opaque_s(bid);
    const int lane = tid & 63, w = __builtin_amdgcn_readfirstlane(tid >> 6), l15 = lane & 15, q4 = lane >> 4;
    LAS bf16_t* QB = (LAS bf16_t*)(lds + 0);
    LAS bf16_t* KS = (LAS bf16_t*)(lds + 17408);
    LAS bf16_t* VT = (LAS bf16_t*)(lds + 35840);
    LAS bf16_t* ST = (LAS bf16_t*)(lds + 54272);
    LAS float* PF = (LAS float*)(lds + 89088);
    LAS float* ssqp = (LAS float*)(lds + 89600);
    LAS float* nw = (LAS float*)(lds + 91648);
    LAS bf16_t* Aq = (LAS bf16_t*)(lds + 92160);
    const int pr = tid >> 3, pp = tid & 7;
    for (int v = bid; v < 256; v += G) {
        const int qd = (v >> 3) & 3, unit = (v & 7) + 8 * (v >> 5);
        const int b = unit >> 3, h = unit & 7; const size_t mb = (size_t)b * SEQ; const int item0 = unit * 64;
        __syncthreads();
        if (tid < 128) nw[tid] = normw[h * 128 + tid];
        for (int i = tid; i < 128 * 136 / 2; i += 512) ((LAS unsigned*)ST)[i] = 0u;
        f32x4 Sacc[8];
#pragma unroll
        for (int i = 0; i < 8; ++i) Sacc[i] = (f32x4){0.f, 0.f, 0.f, 0.f};
        HsPf PA, PB;
        hs_load(PA, item0, qd, tid, lane, w, l15, q4, QF, GT, VTT, OL, PFg); hs_load(PB, item0 + 1, qd, tid, lane, w, l15, q4, QF, GT, VTT, OL, PFg);
#define HS_STEP(P, cc) do { const size_t m0 = mb + (size_t)(cc) * 64 + 16 * qd; \
            if (tid < 256) *(LAS u32x4*)(QB + sw128(tid >> 4, 8 * (tid & 15))) = P.pqb; \
            _Pragma("unroll") for (int j = 0; j < 2; ++j) { const int p = tid + 512 * j; *(LAS u32x4*)(KS + sw64(p >> 3, 8 * (p & 7))) = P.pks[j]; } \
            *(LAS u32x4*)(VT + pr * 72 + 8 * pp) = P.pv0; *(LAS u32x4*)(VT + (64 + pr) * 72 + 8 * pp) = P.pv1; \
            if (tid < 32) *(LAS f32x4*)(PF + 4 * tid) = P.ppf; \
            if (tid < 128) *(LAS u32x4*)(Aq + pr * 72 + 8 * pp) = P.pam; \
            const u32x2 gg = P.pgt; \
            __syncthreads(); \
            { const int cn = ((cc) + 2 < 64) ? (cc) + 2 : 63; hs_load(P, item0 + cn, qd, tid, lane, w, l15, q4, QF, GT, VTT, OL, PFg); } \
            f32x4 ov = (f32x4){0.f, 0.f, 0.f, 0.f}; \
            bf16x8 vf[2]; \
            _Pragma("unroll") for (int kk = 0; kk < 2; ++kk) vf[kk] = *(const LAS bf16x8*)(VT + sw64(16 * w + l15, 32 * kk + 8 * q4)); \
            { bf16x8 sf[4], qf[4], af[2]; \
              _Pragma("unroll") for (int kk = 0; kk < 4; ++kk) { sf[kk] = *(const LAS bf16x8*)(ST + sw128(16 * w + l15, 32 * kk + 8 * q4)); qf[kk] = *(const LAS bf16x8*)(QB + sw128(l15, 32 * kk + 8 * q4)); } \
              _Pragma("unroll") for (int kk = 0; kk < 2; ++kk) af[kk] = *(const LAS bf16x8*)(Aq + l15 * 72 + 32 * kk + 8 * q4); \
              _Pragma("unroll") for (int kk = 0; kk < 2; ++kk) ov = MFMA16(vf[kk], af[kk], ov); \
              _Pragma("unroll") for (int kk = 0; kk < 4; ++kk) ov = MFMA16(sf[kk], qf[kk], ov); } \
            { \
              _Pragma("unroll") for (int dh = 0; dh < 2; ++dh) { bf16x8 kf[4][2]; \
                  _Pragma("unroll") for (int kk = 0; kk < 2; ++kk) _Pragma("unroll") for (int dq = 0; dq < 4; ++dq) kf[dq][kk] = *(const LAS bf16x8*)(KS + sw64(16 * (4 * dh + dq) + l15, 32 * kk + 8 * q4)); \
                  _Pragma("unroll") for (int dq = 0; dq < 4; ++dq) { const int di = 4 * dh + dq; const f32x4 pf = *(const LAS f32x4*)(PF + 16 * di + 4 * q4); Sacc[di] = Sacc[di] * pf; \
                      _Pragma("unroll") for (int kk = 0; kk < 2; ++kk) Sacc[di] = MFMA16(kf[dq][kk], vf[kk], Sacc[di]); } } } \
            { const float p = rows4_sum((ov[0] * ov[0] + ov[1] * ov[1]) + (ov[2] * ov[2] + ov[3] * ov[3])); if (lane < 16) ssqp[lane * 8 + w] = p; } \
            __syncthreads(); \
            _Pragma("unroll") for (int di = 0; di < 8; ++di) { u32x2 o; o.x = pk2_acc(Sacc[di][0], Sacc[di][1]); o.y = pk2_acc(Sacc[di][2], Sacc[di][3]); *(LAS u32x2*)(ST + sw128(16 * w + l15, 16 * di + 4 * q4)) = o; } \
            { const f32x4 nw4 = *(const LAS f32x4*)(nw + 16 * w + 4 * q4); \
              const f32x4 s0 = *(const LAS f32x4*)(ssqp + l15 * 8), s1 = *(const LAS f32x4*)(ssqp + l15 * 8 + 4); \
              const float ssum = ((s0[0] + s0[1]) + (s0[2] + s0[3])) + ((s1[0] + s1[1]) + (s1[2] + s1[3])); \
              const float rstd = rsqrtf(ssum * (1.f / 128.f) + EPS); \
              const float g0 = bf2f_lo(gg.x), g1 = bf2f_hi(gg.x), g2 = bf2f_lo(gg.y), g3 = bf2f_hi(gg.y); \
              u32x2 o; o.x = pk2(ov[0] * rstd * nw4[0] * g0, ov[1] * rstd * nw4[1] * g1); o.y = pk2(ov[2] * rstd * nw4[2] * g2, ov[3] * rstd * nw4[3] * g3); \
              *(u32x2*)(hh + (m0 + l15) * D + h * 128 + 16 * w + 4 * q4) = o; } \
        } while (0)
        for (int c = 0; c < 64; c += 2) { HS_STEP(PA, c); HS_STEP(PB, c + 1); }
#undef HS_STEP
    }
}

constexpr int N_PHASES = 34;
#ifndef MK_KIND_MASK
#define MK_KIND_MASK 0x3FFFF
#endif
#define KIND(k) ((MK_KIND_MASK >> (k)) & 1)
#ifndef MK_TWICE_MASK
#define MK_TWICE_MASK 0
#endif
#define TWICE(k, body) do { body; if ((MK_TWICE_MASK >> (k)) & 1) { xcd_barrier(bar); body; } } while (0)
#ifndef MK_CUT
#define MK_CUT 32
#endif
#define tid (wave_s * 64 + lane_id())
#define IN(k) (lo <= (k) && (k) < hi)
#define SEAM(k) do { if (IN(k) && IN((k) + 1)) { if (MK_N_LAUNCHES == 1) xcd_barrier(bar); else if (tid == 0) __hip_atomic_store(ctl + CW_TMO, 0xBAD0u, __ATOMIC_RELAXED, __HIP_MEMORY_SCOPE_AGENT); } } while (0)
#define ws (kws())
#define ctl ((unsigned*)(ws + WS_CTL))
#define mod ((float*)(ws + WS_MOD))
#define xo ((bf16_t*)kout())
#define R1 ((bf16_t*)(ws + WS_R1))
#define HN ((bf16_t*)(ws + WS_R2))
#define YB ((bf16_t*)(ws + WS_R2))
#define LI ((float*)(ws + WS_LI))
#define LF ((float*)(ws + WS_LF))
#define LTOK ((int*)(ws + WS_LTOK))
#define LW ((float*)(ws + WS_LW))


template <int LP>
__device__ __forceinline__ void layer_pair(LAS unsigned char* lds, const int wave_s, const int bid, const int G, const int lo, const int hi, const XcdBarrier& bar) {
        constexpr int lp = LP;
        const int pb = 1 + 16 * lp;
        unsigned char* wb = ws + WS_WGT + (size_t)lp * LP_BYTES;
        unsigned* gcnt = ctl + CW_CNT + 64 * lp;
        { const int L = 2 * lp; const float* modL = mod + (size_t)L * 8 * 6144;
          const bf16_t* hnA = (lp == 0) ? HN : (const bf16_t*)(ws + WS_R1);
          bf16_t* QKR = (bf16_t*)(ws + WS_R1 + (lp == 0 ? 0 : 64) * MiB);
          bf16_t* OGT = (bf16_t*)(ws + WS_R1 + (lp == 0 ? 64 : 128) * MiB);
          bf16_t* VTm = (bf16_t*)(ws + WS_R1 + (lp == 0 ? 128 : 192) * MiB);
          bf16_t* QKT = (bf16_t*)(ws + WS_R1 + (lp == 0 ? 192 : 0) * MiB);
          bf16_t* UU = (bf16_t*)(ws + WS_R2U);
          if (KIND(1) && IN(pb + 0)) {
              if (lp == 0) TWICE(1, (norm_phase<1, false, true>(lds, tid, bid, G, karg(I_X), xo, YB, karg(I_N1W) + L * 1024, modL + 0, modL + 1024, HN, (const float*)(wb + W_MGATE), karg(I_MIB) + lp * 8, karg(I_MFB) + lp * 8, LI, LF, nullptr, nullptr, nullptr)));
              else norm_phase<1, true>(lds, tid, bid, G, xo, xo, YB, karg(I_N1W) + L * 1024, modL + 0, modL + 1024, (bf16_t*)(ws + WS_R1), (const float*)(wb + W_MGATE), karg(I_MIB) + lp * 8, karg(I_MFB) + lp * 8, LI, LF, nullptr, nullptr, nullptr);
          }
          SEAM(pb + 0);
          if (KIND(2) && IN(pb + 1)) {
              { pg8::Gemm g{hnA, (const bf16_t*)(wb + W_MIN), T, 2048, D, 0}; pg8::StaticOrder S; S.init(T, 2048, G, bid);
                pg8::EpiTile<0> E{QKR, OGT, karg(I_MNW) + lp * 1024};
                TWICE(2, (pg8::gemm_phase<pg8::EpiTile<0>, pg8::StaticOrder, true, false>(lds, g, S, E, wave_s))); }
              { pg8::Gemm g{(const bf16_t*)(wb + W_MIN) + (size_t)2048 * 1024, hnA, 1024, T, D, 0}; pg8::StaticOrder S; S.init(1024, T, G, bid);
                pg8::EpiVT E{VTm};
                TWICE(2, (pg8::gemm_phase<pg8::EpiVT, pg8::StaticOrder, true, false>(lds, g, S, E, wave_s))); }
          }
          SEAM(pb + 1);
          if (KIND(16) && IN(pb + 2)) TWICE(16, mlstm_prep(lds, tid, bid, G, QKR, OGT, VTm, LI, LF, (f32x4*)(ws + WS_SCT), (f32x4*)(ws + WS_SCI), karg(I_MCW) + (size_t)lp * 4 * 1024, karg(I_MCB) + lp * 1024, karg(I_MNW) + lp * 1024, QKT, UU));
          SEAM(pb + 2);
          if (KIND(3) && IN(pb + 3)) { TWICE(3, mlstm_scan(lds, tid, bid, G, OGT, VTm, (const f32x4*)(ws + WS_SCT), (const f32x4*)(ws + WS_SCI), QKT, UU, HN));
 }
          SEAM(pb + 3);
          if (KIND(4) && IN(pb + 4)) {
              pg8::Gemm g{HN, (const bf16_t*)(wb + W_MOUT), T, D, D, 0}; pg8::StaticOrder S; S.init(T, D, G, bid);
              if (lp == 0) { pg8::EpiResid<true> E{karg(I_X), xo, modL + 2048}; pg8::gemm_phase<pg8::EpiResid<true>, pg8::StaticOrder, true, false>(lds, g, S, E, wave_s); }
              else { pg8::EpiResid<false> E{xo, xo, modL + 2048}; pg8::gemm_phase<pg8::EpiResid<false>, pg8::StaticOrder, true, false>(lds, g, S, E, wave_s); }
          }
          SEAM(pb + 4);
          if (KIND(5) && IN(pb + 5)) TWICE(5, (norm_phase<0, false>(lds, tid, bid, G, xo, xo, YB, karg(I_N2W) + L * 1024, modL + 3072, modL + 4096, HN, nullptr, nullptr, nullptr, nullptr, nullptr, nullptr, nullptr, nullptr)));
          SEAM(pb + 5);
          if (KIND(6) && IN(pb + 6)) {
              pg8::Gemm g{HN, (const bf16_t*)(wb + W_FGU), T, 2 * DFF, D, 0}; pg8::StaticOrder S; S.init(T, 2 * DFF, G, bid);
              pg8::EpiSwiGLU E{R1, DFF};
              TWICE(6, (pg8::gemm_phase<pg8::EpiSwiGLU, pg8::StaticOrder, true, false>(lds, g, S, E, wave_s)));
          }
          SEAM(pb + 6);
          if (KIND(7) && IN(pb + 7)) {
              pg8::Gemm g{R1, (const bf16_t*)(wb + W_FD), T, D, DFF, 0}; pg8::StaticOrder S; S.init(T, D, G, bid);
              pg8::EpiResid<false> E{xo, xo, modL + 5120};
              pg8::gemm_phase<pg8::EpiResid<false>, pg8::StaticOrder, true, false>(lds, g, S, E, wave_s);
          }
          SEAM(pb + 7);
        }
        { const int L = 2 * lp + 1; const float* modL = mod + (size_t)L * 8 * 6144;
          bf16_t* QF = R1;
          bf16_t* GT = (bf16_t*)(ws + WS_R1 + 128 * MiB);
          bf16_t* VTh = (bf16_t*)(ws + WS_R1 + 192 * MiB);
          bf16_t* OL = (bf16_t*)(ws + WS_R2U);
          float* PFg = (float*)(ws + WS_RS);
          if (KIND(8) && IN(pb + 8)) norm_phase<0, false>(lds, tid, bid, G, xo, xo, YB, karg(I_N1W) + L * 1024, modL + 0, modL + 1024, HN, nullptr, nullptr, nullptr, nullptr, nullptr, nullptr, nullptr, nullptr);
          SEAM(pb + 8);
          if (KIND(9) && IN(pb + 9)) {
              { pg8::Gemm g{HN, (const bf16_t*)(wb + W_HIN), T, 3072, D, 0}; pg8::StaticOrder S; S.init(T, 3072, G, bid);
                pg8::EpiTile<1> E{QF, GT, (lp == 0) ? nullptr : (const float*)(ws + WS_LB)};
                TWICE(9, (pg8::gemm_phase<pg8::EpiTile<1>, pg8::StaticOrder, true, false>(lds, g, S, E, wave_s))); }
              { pg8::Gemm g{(const bf16_t*)(wb + W_HIN) + (size_t)3072 * 1024, HN, 1024, T, D, 0}; pg8::StaticOrder S; S.init(1024, T, G, bid);
                pg8::EpiVT E{VTh};
                TWICE(9, (pg8::gemm_phase<pg8::EpiVT, pg8::StaticOrder, true, false>(lds, g, S, E, wave_s))); }
          }
          SEAM(pb + 9);
          if (KIND(17) && IN(pb + 10)) TWICE(17, hgrn_prep(lds, tid, bid, G, QF, VTh, OL, PFg));
          SEAM(pb + 10);
          if (KIND(10) && IN(pb + 11)) TWICE(10, hgrn_scan(lds, tid, bid, G, QF, GT, VTh, OL, PFg, karg(I_HNW) + lp * 1024, HN));
          SEAM(pb + 11);
          if (KIND(11) && IN(pb + 12)) {
              pg8::Gemm g{HN, (const bf16_t*)(wb + W_HOUT), T, D, D, 0}; pg8::StaticOrder S; S.init(T, D, G, bid);
              pg8::EpiResid<false> E{xo, xo, modL + 2048};
              pg8::gemm_phase<pg8::EpiResid<false>, pg8::StaticOrder, true, false>(lds, g, S, E, wave_s);
          }
          SEAM(pb + 12);
          if (KIND(12) && IN(pb + 13)) norm_phase<2, false>(lds, tid, bid, G, xo, xo, YB, karg(I_N2W) + L * 1024, modL + 3072, modL + 4096, HN, (const float*)(wb + W_ROUT), nullptr, nullptr, nullptr, nullptr, gcnt, LTOK, LW);
          SEAM(pb + 13);
          if (KIND(13) && IN(pb + 14)) {
              pg8::Gemm g{HN, (const bf16_t*)(wb + W_EGU), T, 2 * DFE, D, (size_t)2 * DFE * D}; pg8::MoeOrder S; S.init(gcnt, LTOK, (2 * DFE) / 256, G, bid, (LAS int*)(lds + MISC_OFF + 64), wave_s);
              pg8::EpiSwiGLU E{R1, DFE};
              TWICE(13, (pg8::gemm_phase<pg8::EpiSwiGLU, pg8::MoeOrder, true, true>(lds, g, S, E, wave_s)));
              if (lp == 0) tail_convert(lds, tid, bid, G, S.nwg, CV_PER_LP, CV_PER_LP + CV_TAIL1);
          }
          SEAM(pb + 14);
          if (KIND(14) && IN(pb + 15)) {
              pg8::Gemm g{R1, (const bf16_t*)(wb + W_ED), T, D, DFE, (size_t)D * DFE}; pg8::MoeOrder S; S.init(gcnt, LTOK, D / 256, G, bid, (LAS int*)(lds + MISC_OFF + 64), wave_s);
              pg8::EpiMoeDown E{YB, LTOK, LW, gcnt, modL + 5120};
              TWICE(14, (pg8::gemm_phase<pg8::EpiMoeDown, pg8::MoeOrder, true, false>(lds, g, S, E, wave_s)));
              if (lp == 0) tail_convert(lds, tid, bid, G, S.nwg, CV_PER_LP + CV_TAIL1, 2 * CV_PER_LP);
          }
          SEAM(pb + 15);
        }
}

__global__ void __launch_bounds__(512, 2) mk_fwd(Args args) {
    extern __shared__ __attribute__((aligned(16))) unsigned char lds_raw[];
    LAS unsigned char* lds = (LAS unsigned char*)lds_raw;
    const int wave_s = __builtin_amdgcn_readfirstlane((int)threadIdx.x >> 6);
    const int bid = blockIdx.x, G = gridDim.x;
    volatile LAS unsigned* MISC = (volatile LAS unsigned*)(lds + MISC_OFF);
    if (tid < 64) MISC[tid] = 0u;
    __syncthreads();
    XcdBarrier bar; bar.bar = (unsigned*)(kws() + WS_CTL) + CW_BAR; bar.x = 0; bar.st = nullptr; bar.wv = wave_s;
    if (MK_N_LAUNCHES == 1) bar = xcd_barrier_post((unsigned*)(kws() + WS_CTL) + CW_BAR, MISC, wave_s);
    const int lo = __builtin_amdgcn_readfirstlane(args.ph_lo), hi = __builtin_amdgcn_readfirstlane(args.ph_hi);
    if (KIND(0) && IN(0)) { TWICE(0, p0_phase(lds, tid, bid, G)); }
    SEAM(0);
    layer_pair<0>(lds, wave_s, bid, G, lo, hi, bar);
    layer_pair<1>(lds, wave_s, bid, G, lo, hi, bar);
    if (KIND(15) && IN(33)) { if (MK_CUT >= 32 || MK_CUT == 16) final_phase<true>(tid, bid, G, kout(), YB, karg(I_FNW)); else final_phase<false>(tid, bid, G, kout(), YB, karg(I_FNW)); }
#undef IN
#undef SEAM
#undef tid
#undef ws
#undef ctl
#undef mod
#undef xo
#undef R1
#undef HN
#undef YB
#undef LI
#undef LF
#undef LTOK
#undef LW
}

extern "C" void kernel_launch(void* const* d_in, const int* in_sizes, int n_in, void* d_out, int out_size, void* d_ws, size_t ws_size, hipStream_t stream) {
    static int grid = 0;
    if (grid == 0) {
        if (n_in != 25 || in_sizes[0] != T * D || out_size != T * D || ws_size < WS_END2) {
            fprintf(stderr, "kernel_launch: unexpected shapes (n_in %d, in0 %d, out %d, ws %zu < %zu)\n", n_in, n_in > 0 ? in_sizes[0] : -1, out_size, ws_size, (size_t)WS_END2); grid = -1; }
        else {
            int dev = 0, cus = 0;
            if (hipGetDevice(&dev) != hipSuccess || hipDeviceGetAttribute(&cus, hipDeviceAttributeMultiprocessorCount, dev) != hipSuccess) { grid = -1; }
            else if (hipFuncSetAttribute((const void*)mk_fwd, hipFuncAttributeMaxDynamicSharedMemorySize, LDS_BYTES) != hipSuccess) { fprintf(stderr, "kernel_launch: hipFuncSetAttribute failed\n"); grid = -1; }
            else { int per_cu = 0; (void)hipOccupancyMaxActiveBlocksPerMultiprocessor(&per_cu, (const void*)mk_fwd, 512, LDS_BYTES); (void)hipGetLastError();
                if (per_cu < 1) fprintf(stderr, "kernel_launch: occupancy query reports %d blocks per CU\n", per_cu);
                grid = cus; }
        }
    }
    if (grid < 0) { (void)hipMemsetAsync(d_out, 0xFF, (size_t)out_size * 4, stream); return; }
    (void)hipMemsetAsync((char*)d_ws + WS_CTL, 0, CTL_ZERO_BYTES, stream);
    Args a{};
    for (int i = 0; i < 25; ++i) a.in[i] = (const float*)d_in[i];
    a.out = (float*)d_out; a.ws = (unsigned char*)d_ws;
    if (MK_N_LAUNCHES == 1) { a.ph_lo = 0; a.ph_hi = N_PHASES; hipLaunchKernelGGL(mk_fwd, dim3(grid), dim3(512), LDS_BYTES, stream, a); }
    else { for (int p = 0; p < N_PHASES; ++p) { if (p > MK_CUT && p != N_PHASES - 1) continue; a.ph_lo = p; a.ph_hi = p + 1; hipLaunchKernelGGL(mk_fwd, dim3(grid), dim3(512), LDS_BYTES, stream, a); } }
}
```

```cpp
#include <hip/hip_runtime.h>
#include <cstdio>
#include <cstdint>

#ifndef MK_N_LAUNCHES
#define MK_N_LAUNCHES 1
#endif

#define LAS __attribute__((address_space(3)))
#define GAS __attribute__((address_space(1)))
typedef unsigned short bf16_t;
typedef short bf16x8 __attribute__((ext_vector_type(8)));
typedef float f32x4 __attribute__((ext_vector_type(4)));
typedef float f32x2 __attribute__((ext_vector_type(2)));
typedef unsigned u32x4 __attribute__((ext_vector_type(4)));
typedef unsigned u32x2 __attribute__((ext_vector_type(2)));

constexpr int BATCH = 8, SEQ = 4096, D = 1024, T = BATCH * SEQ;
constexpr int MPROJ = 3088, MPROJ_G = 3072;
constexpr int HPROJ = 4096;
constexpr int DFF = 2816, NE = 8, DFE = 1408;
constexpr float EPS = 1e-6f;
constexpr int XP = 2048;

constexpr size_t MiB = 1u << 20;
constexpr size_t WS_CTL = 0, CTL_ZERO_BYTES = 65536;
constexpr int CW_TMO = 0, CW_BAR = 4096, CW_CNT = 8192;
constexpr size_t WS_MOD = 1 * MiB;
constexpr size_t WS_LB = WS_MOD + (size_t)4 * 8 * 6144 * 4;
constexpr size_t WS_LI = 2 * MiB, WS_LF = 3 * MiB;
constexpr size_t WS_LTOK = 4 * MiB, WS_LW = 5 * MiB;
constexpr size_t WS_RS = 6 * MiB, WS_KN = 7 * MiB;
constexpr size_t WS_WGT = 8 * MiB;
constexpr size_t W_MIN = 0;
constexpr size_t W_MGATE = W_MIN + (size_t)3072 * 1024 * 2;
constexpr size_t W_MOUT = W_MGATE + 16 * 1024 * 4;
constexpr size_t W_FGU = W_MOUT + (size_t)1024 * 1024 * 2;
constexpr size_t W_FD = W_FGU + (size_t)5632 * 1024 * 2;
constexpr size_t W_HIN = W_FD + (size_t)1024 * 2816 * 2;
constexpr size_t W_HOUT = W_HIN + (size_t)4096 * 1024 * 2;
constexpr size_t W_ROUT = W_HOUT + (size_t)1024 * 1024 * 2;
constexpr size_t W_EGU = W_ROUT + 8 * 1024 * 4;
constexpr size_t W_ED = W_EGU + (size_t)8 * 2816 * 1024 * 2;
constexpr size_t LP_BYTES = W_ED + (size_t)8 * 1024 * 1408 * 2;
constexpr size_t WS_R1 = ((WS_WGT + 2 * LP_BYTES + MiB - 1) / MiB) * MiB;
constexpr size_t WS_R2 = WS_R1 + 256 * MiB;
constexpr size_t WS_END = WS_R2 + 128 * MiB;
constexpr size_t WS_SCT = WS_END, WS_SCI = WS_END + 4 * MiB, WS_END2 = WS_END + 8 * MiB;
constexpr size_t WS_R2U = WS_R2 + 64 * MiB;
static_assert(LP_BYTES % 16 == 0 && W_MGATE % 16 == 0 && W_ROUT % 16 == 0, "alignment");

constexpr int LDS_BYTES = 163840;
constexpr int MISC_OFF = LDS_BYTES - 256;

__device__ __forceinline__ float bf2f_lo(unsigned w) { return __builtin_bit_cast(float, w << 16); }
__device__ __forceinline__ float bf2f_hi(unsigned w) { return __builtin_bit_cast(float, w & 0xffff0000u); }
__device__ __forceinline__ float bf2f(unsigned short u) { return __builtin_bit_cast(float, (unsigned)u << 16); }
__device__ __forceinline__ unsigned f2bf(float f) { unsigned u = __builtin_bit_cast(unsigned, f); return (u + 0x7fffu + ((u >> 16) & 1u)) >> 16; }
__device__ __forceinline__ unsigned pk2(float lo, float hi) { unsigned r; asm volatile("v_cvt_pk_bf16_f32 %0, %1, %2" : "=v"(r) : "v"(lo), "v"(hi)); return r; }
typedef __bf16 bf16x2_t __attribute__((ext_vector_type(2)));
__device__ __forceinline__ unsigned pk2_acc(float lo, float hi) { const f32x2 v = {lo, hi}; const bf16x2_t b = __builtin_convertvector(v, bf16x2_t); return __builtin_bit_cast(unsigned, b); }
__device__ __forceinline__ float wave_sum(float v) {
#pragma unroll
    for (int o = 1; o < 64; o <<= 1) v += __shfl_xor(v, o);
    return v;
}
__device__ __forceinline__ float sigmoidf_(float x) { return __builtin_amdgcn_rcpf(1.f + __expf(-x)); }
__device__ __forceinline__ float siluf_(float x) { return x * __builtin_amdgcn_rcpf(1.f + __expf(-x)); }
__device__ __forceinline__ int lane_id() { return (int)__builtin_amdgcn_mbcnt_hi(~0u, __builtin_amdgcn_mbcnt_lo(~0u, 0u)); }
__device__ __forceinline__ int opaque_v(int x) { asm volatile("" : "+v"(x)); return x; }
__device__ __forceinline__ int opaque_s(int x) { asm volatile("" : "+s"(x)); return x; }
__device__ __forceinline__ float rows4_sum(float p) { p += __shfl_xor(p, 16); p += __shfl_xor(p, 32); return p; }
#define MFMA16(a, b, c) __builtin_amdgcn_mfma_f32_16x16x32_bf16((a), (b), (c), 0, 0, 0)
#define LDS_ADDF(p, v) __hip_atomic_fetch_add((p), (v), __ATOMIC_RELAXED, __HIP_MEMORY_SCOPE_WORKGROUP)

namespace pg8 {
#define PG8_LAS __attribute__((address_space(3)))
constexpr int BM = 256, BK = 64, HALF = 128, HTB = HALF * BK * 2, STAGE_BYTES = 8 * HTB, NXCD = 8, WGM = 8;
__host__ __device__ __forceinline__ int lds_byte(int r, int c) { const int st = (r >> 4) * 2 + (c >> 5), rr = r & 15, cc = c & 31, ob = rr * 64 + cc * 2; return st * 1024 + (ob ^ (((ob >> 9) & 1) << 5)); }
__host__ __device__ __forceinline__ void stage_rc(int b, int& R, int& C) { const int st = b / 1024, sb = b % 1024, swz = sb ^ (((sb >> 9) & 1) << 5); R = (st >> 1) * 16 + swz / 64; C = (st & 1) * 32 + (swz % 64) / 2; }
__host__ __device__ __forceinline__ int perm32(int rho) { const int n = rho >> 4, i = rho & 15; return 8 * (i >> 2) + 4 * n + (i & 3); }

struct Unit { int pm, pn, e, lrow; };
struct Gemm { const bf16_t* A; const bf16_t* Bt; int M, N, K; size_t bexp; };

struct StaticOrder {
    int nM, nN, nwg, G, c;
    __device__ __forceinline__ void init(int M, int N, int G_, int c_) { nM = M / BM; nN = N / BM; nwg = nM * nN; G = G_; c = c_; }
    __device__ __forceinline__ bool next(int i, Unit& u) const {
        const long L = (long)i * G + c; if (L >= nwg) return false;
        int wgid = (int)L; { const int q = nwg / NXCD, r = nwg % NXCD, xcd = wgid % NXCD, off = wgid / NXCD; wgid = (xcd < r ? xcd * (q + 1) : r * (q + 1) + (xcd - r) * q) + off; }
        const int nig = WGM * nN, gid = wgid / nig, fm = gid * WGM, gsz = (nM - fm) < WGM ? (nM - fm) : WGM;
        u.pm = fm + ((wgid % nig) % gsz); u.pn = (wgid % nig) / gsz; u.e = 0; u.lrow = 0; return true;
    }
    __device__ __forceinline__ int row_index(const Unit&, int) const { return 0; }
};
struct MoeOrder {
    int nM, nN, nwg, G, c; const PG8_LAS int* tab; const int* lst; const unsigned* cnt;
    __device__ __forceinline__ void init(const unsigned* cnt_, const int* lst_, int nN_, int G_, int c_, PG8_LAS int* tab_, int wid) {
        if (wid == 0 && lane_id() == 0) { int acc = 0; tab_[0] = 0;
            for (int e = 0; e < 8; ++e) { int v = (int)cnt_[e]; v = v < 0 ? 0 : (v > T ? T : v); tab_[16 + e] = v; acc += (v + 255) / 256; tab_[e + 1] = acc; } }
        __syncthreads();
        tab = tab_; nM = tab_[8]; nN = nN_; nwg = nM * nN; G = G_; c = c_; lst = lst_; cnt = cnt_;
    }
    __device__ __forceinline__ bool next(int i, Unit& u) const {
        const long L = (long)i * G + c; if (L >= nwg) return false;
        int wgid = (int)L; { const int q = nwg / NXCD, r = nwg % NXCD, xcd = wgid % NXCD, off = wgid / NXCD; wgid = (xcd < r ? xcd * (q + 1) : r * (q + 1) + (xcd - r) * q) + off; }
        const int nig = WGM * nN, gid = wgid / nig, fm = gid * WGM, gsz = (nM - fm) < WGM ? (nM - fm) : WGM;
        u.pm = fm + ((wgid % nig) % gsz); u.pn = (wgid % nig) / gsz;
        int e = 0;
        for (int k = 1; k < 8; ++k) { if (u.pm >= tab[k]) e = k; }
        u.e = e; u.lrow = (u.pm - tab[e]) * 256; return true;
    }
    __device__ __forceinline__ int row_index(const Unit& u, int r) const {
        const int pos = u.lrow + r; const int n = tab[16 + u.e];
        const int v = lst[(size_t)u.e * T + (pos < n ? pos : 0)] >> 1;
        return pos < n ? v : 0;
    }
};

template <int MODE> struct EpiBf16 {
    static constexpr bool PERM = true, AFTER_DRAIN = false;
    bf16_t* O; int ldc; const float* lb;
    __device__ __forceinline__ void operator()(const f32x4 (&acc)[2][2][4][2], const Unit& u, int wr, int wc, int fr, int fq) const {
        const int row0 = u.pm * BM + wr * 64 + fr; const int col0 = u.pn * BM + wc * 32 + 8 * fq;
        const int kind = (MODE == 1) ? (u.pn >> 2) : 2;
        f32x4 lbv[2][2];
        if (MODE == 1 && kind == 1) {
#pragma unroll
            for (int bj = 0; bj < 2; ++bj)
#pragma unroll
                for (int n = 0; n < 2; ++n) lbv[bj][n] = lb ? *(const f32x4*)(lb + (col0 - 1024) + bj * HALF + 4 * n) : (f32x4){0.f, 0.f, 0.f, 0.f};
        }
#pragma unroll
        for (int ai = 0; ai < 2; ++ai)
#pragma unroll
            for (int m = 0; m < 4; ++m) { bf16_t* rowp = O + (size_t)(row0 + ai * HALF + m * 16) * ldc + col0;
#pragma unroll
                for (int bj = 0; bj < 2; ++bj) { f32x4 v0 = acc[ai][bj][m][0], v1 = acc[ai][bj][m][1];
                    if (MODE == 1) {
                        if (kind == 0 || kind == 2) {
#pragma unroll
                            for (int j = 0; j < 4; ++j) { v0[j] = siluf_(v0[j]); v1[j] = siluf_(v1[j]); }
                        } else if (kind == 1) {
#pragma unroll
                            for (int j = 0; j < 4; ++j) { const float l0 = lbv[bj][0][j], l1 = lbv[bj][1][j];
                                v0[j] = logf(fmaxf(l0 + (1.f - l0) * sigmoidf_(v0[j]), 1e-30f)); v1[j] = logf(fmaxf(l1 + (1.f - l1) * sigmoidf_(v1[j]), 1e-30f)); }
                        }
                    }
                    u32x4 w; w.x = pk2(v0[0], v0[1]); w.y = pk2(v0[2], v0[3]); w.z = pk2(v1[0], v1[1]); w.w = pk2(v1[2], v1[3]);
                    *(u32x4*)(rowp + bj * HALF) = w; } }
    }
};
template <int KIND> struct EpiTile {
    static constexpr bool PERM = true, AFTER_DRAIN = false;
    bf16_t* QK; bf16_t* OG; const float* lb;
    __device__ __forceinline__ void operator()(const f32x4 (&acc)[2][2][4][2], const Unit& u, int wr, int wc, int fr, int fq) const {
        constexpr int HD = (KIND == 0) ? 64 : 128, NQK = 2 * 8 * HD;
        const int row0 = u.pm * BM + wr * 64 + fr;
#pragma unroll
        for (int bj = 0; bj < 2; ++bj) { const int c = u.pn * BM + bj * HALF + wc * 32 + 8 * fq;
            const bool isqk = c < NQK; const int which = isqk ? (c / (8 * HD)) : 0; const int cc = isqk ? (c % (8 * HD)) : (c - NQK);
            const int h = isqk ? (cc / HD) : (cc >> 7), d = isqk ? (cc % HD) : (cc & 127);
            f32x4 l0 = (f32x4){0.f, 0.f, 0.f, 0.f}, l1 = l0;
            if (KIND == 1 && isqk && which == 1 && lb) { l0 = *(const f32x4*)(lb + h * 128 + d); l1 = *(const f32x4*)(lb + h * 128 + d + 4); }
            if (KIND == 0 && !isqk) { l0 = *(const f32x4*)(lb + h * 128 + d); l1 = *(const f32x4*)(lb + h * 128 + d + 4); }
#pragma unroll
            for (int ai = 0; ai < 2; ++ai)
#pragma unroll
                for (int m = 0; m < 4; ++m) { const int r = row0 + ai * HALF + m * 16; const int item = (((r >> 12) * 8 + h) << 6) + ((r >> 6) & 63), t = r & 63;
                    f32x4 v0 = acc[ai][bj][m][0], v1 = acc[ai][bj][m][1];
                    if (KIND == 0 && !isqk) {
#pragma unroll
                        for (int j = 0; j < 4; ++j) { v0[j] = sigmoidf_(v0[j]) * l0[j]; v1[j] = sigmoidf_(v1[j]) * l1[j]; }
                    }
                    if (KIND == 1) {
                        if (isqk && which == 1) {
#pragma unroll
                            for (int j = 0; j < 4; ++j) { v0[j] = __logf(fmaxf(l0[j] + (1.f - l0[j]) * sigmoidf_(v0[j]), 1e-30f)); v1[j] = __logf(fmaxf(l1[j] + (1.f - l1[j]) * sigmoidf_(v1[j]), 1e-30f)); }
                        } else {
#pragma unroll
                            for (int j = 0; j < 4; ++j) { v0[j] = siluf_(v0[j]); v1[j] = siluf_(v1[j]); }
                        }
                    }
                    u32x4 w; w.x = pk2(v0[0], v0[1]); w.y = pk2(v0[2], v0[3]); w.z = pk2(v1[0], v1[1]); w.w = pk2(v1[2], v1[3]);
                    bf16_t* p = isqk ? (QK + ((size_t)(item * 2 + which) * 64 + t) * HD + d) : (OG + ((size_t)item * 64 + t) * 128 + d);
                    *(u32x4*)p = w; } }
    }
};
struct EpiVT {
    static constexpr bool PERM = true, AFTER_DRAIN = false;
    bf16_t* VT;
    __device__ __forceinline__ void operator()(const f32x4 (&acc)[2][2][4][2], const Unit& u, int wr, int wc, int fr, int fq) const {
        const int row0 = u.pm * BM + wr * 64 + fr;
#pragma unroll
        for (int bj = 0; bj < 2; ++bj) { const int tok = u.pn * BM + bj * HALF + wc * 32 + 8 * fq; const int b = tok >> 12, ch = (tok >> 6) & 63, s = tok & 63;
#pragma unroll
            for (int ai = 0; ai < 2; ++ai)
#pragma unroll
                for (int m = 0; m < 4; ++m) { const int c = row0 + ai * HALF + m * 16; const int h = c >> 7, dv = c & 127; const int item = ((b * 8 + h) << 6) + ch;
                    const f32x4 v0 = acc[ai][bj][m][0], v1 = acc[ai][bj][m][1];
                    u32x4 w; w.x = pk2(v0[0], v0[1]); w.y = pk2(v0[2], v0[3]); w.z = pk2(v1[0], v1[1]); w.w = pk2(v1[2], v1[3]);
                    *(u32x4*)(VT + ((size_t)item * 128 + dv) * 64 + s) = w; } }
    }
};
template <bool XIN_F32> struct EpiResid {
    static constexpr bool PERM = true, AFTER_DRAIN = false;
    const void* xin; bf16_t* xout; const float* gate;
    __device__ __forceinline__ void operator()(const f32x4 (&acc)[2][2][4][2], const Unit& u, int wr, int wc, int fr, int fq) const {
        const int row0 = u.pm * BM + wr * 64 + fr, col0 = u.pn * BM + wc * 32 + 8 * fq; const int b = u.pm >> 4;
        f32x4 gv[2][2];
#pragma unroll
        for (int bj = 0; bj < 2; ++bj)
#pragma unroll
            for (int n = 0; n < 2; ++n) gv[bj][n] = *(const f32x4*)(gate + (size_t)b * 6144 + col0 + bj * HALF + n * 4);
#pragma unroll
        for (int ai = 0; ai < 2; ++ai) {
            f32x4 x0[4][2], x1[4][2];
#pragma unroll
            for (int m = 0; m < 4; ++m) { const size_t row = (size_t)(row0 + ai * HALF + m * 16);
#pragma unroll
                for (int bj = 0; bj < 2; ++bj) {
                    if (XIN_F32) { const float* p = (const float*)xin + row * D + col0 + bj * HALF; x0[m][bj] = *(const f32x4*)p; x1[m][bj] = *(const f32x4*)(p + 4); }
                    else { const u32x4 v = *(const u32x4*)((const bf16_t*)xin + row * XP + col0 + bj * HALF);
                        x0[m][bj] = (f32x4){bf2f_lo(v.x), bf2f_hi(v.x), bf2f_lo(v.y), bf2f_hi(v.y)}; x1[m][bj] = (f32x4){bf2f_lo(v.z), bf2f_hi(v.z), bf2f_lo(v.w), bf2f_hi(v.w)}; } } }
            asm volatile("" ::: "memory");
#pragma unroll
            for (int m = 0; m < 4; ++m) { const size_t row = (size_t)(row0 + ai * HALF + m * 16);
#pragma unroll
                for (int bj = 0; bj < 2; ++bj) {
                    const f32x4 y0 = x0[m][bj] + gv[bj][0] * acc[ai][bj][m][0], y1 = x1[m][bj] + gv[bj][1] * acc[ai][bj][m][1];
                    u32x4 o; o.x = pk2(y0[0], y0[1]); o.y = pk2(y0[2], y0[3]); o.z = pk2(y1[0], y1[1]); o.w = pk2(y1[2], y1[3]);
                    *(u32x4*)(xout + row * XP + col0 + bj * HALF) = o; } }
            asm volatile("" ::: "memory");
        }
    }
};
struct EpiSwiGLU {
    static constexpr bool PERM = true, AFTER_DRAIN = false;
    bf16_t* O; int ldc;
    __device__ __forceinline__ void operator()(const f32x4 (&acc)[2][2][4][2], const Unit& u, int wr, int wc, int fr, int fq) const {
        const int row0 = u.pm * BM + wr * 64 + fr; const int col0 = u.pn * HALF + wc * 32 + 8 * fq;
#pragma unroll
        for (int ai = 0; ai < 2; ++ai)
#pragma unroll
            for (int m = 0; m < 4; ++m) { bf16_t* rowp = O + (size_t)(row0 + ai * HALF + m * 16) * ldc + col0;
                f32x4 v0, v1;
#pragma unroll
                for (int j = 0; j < 4; ++j) { v0[j] = siluf_(acc[ai][0][m][0][j]) * acc[ai][1][m][0][j]; v1[j] = siluf_(acc[ai][0][m][1][j]) * acc[ai][1][m][1][j]; }
                u32x4 w; w.x = pk2(v0[0], v0[1]); w.y = pk2(v0[2], v0[3]); w.z = pk2(v1[0], v1[1]); w.w = pk2(v1[2], v1[3]);
                *(u32x4*)rowp = w; }
    }
};
struct EpiMoeDown {
    static constexpr bool PERM = true, AFTER_DRAIN = false;
    bf16_t* Y; const int* lst; const float* lw; const unsigned* cnt; const float* gate;
    __device__ __forceinline__ void operator()(const f32x4 (&acc)[2][2][4][2], const Unit& u, int wr, int wc, int fr, int fq) const {
        const int col0 = u.pn * BM + wc * 32 + 8 * fq; const int n_e = (int)cnt[u.e];
        int tsv[2][4]; float wv[2][4];
#pragma unroll
        for (int ai = 0; ai < 2; ++ai)
#pragma unroll
            for (int m = 0; m < 4; ++m) { const int pos = u.lrow + ai * HALF + wr * 64 + m * 16 + fr; const size_t q = (size_t)u.e * T + (pos < n_e ? pos : 0); tsv[ai][m] = lst[q]; wv[ai][m] = lw[q]; }
#pragma unroll
        for (int ai = 0; ai < 2; ++ai)
#pragma unroll
            for (int mp = 0; mp < 2; ++mp) {
                f32x4 g[2][2][2];
#pragma unroll
                for (int mm = 0; mm < 2; ++mm) { const int m = 2 * mp + mm; const int b = tsv[ai][m] >> 13;
                    const float* gp = gate + (size_t)b * 6144 + col0;
#pragma unroll
                    for (int bj = 0; bj < 2; ++bj) { g[mm][bj][0] = *(const f32x4*)(gp + bj * HALF); g[mm][bj][1] = *(const f32x4*)(gp + bj * HALF + 4); } }
#pragma unroll
                for (int mm = 0; mm < 2; ++mm) { const int m = 2 * mp + mm; const int pos = u.lrow + ai * HALF + wr * 64 + m * 16 + fr;
                    if (pos < n_e) { bf16_t* rowp = Y + (size_t)tsv[ai][m] * D + col0; const float w = wv[ai][m];
#pragma unroll
                        for (int bj = 0; bj < 2; ++bj) { const f32x4 v0 = acc[ai][bj][m][0] * g[mm][bj][0] * w, v1 = acc[ai][bj][m][1] * g[mm][bj][1] * w;
                            u32x4 o; o.x = pk2(v0[0], v0[1]); o.y = pk2(v0[2], v0[3]); o.z = pk2(v1[0], v1[1]); o.w = pk2(v1[2], v1[3]);
                            *(u32x4*)(rowp + bj * HALF) = o; } } }
            }
    }
};

template <class Epi, class Sched, bool ALIGN_EPI, bool GATHER>
__device__ __forceinline__ void gemm_phase(PG8_LAS unsigned char* lds, const Gemm g, const Sched& S, const Epi& E, const int wid) {
    const int lane = opaque_v(lane_id()), tid = wid * 64 + lane, wr = wid >> 2, wc = wid & 3, fr = lane & 15, fq = lane >> 4;
    const int K = g.K, nt = K / BK;
    unsigned voffA[2], voffB[2];
#pragma unroll
    for (int i = 0; i < 2; ++i) { int R, C; stage_rc(tid * 16 + i * 8192, R, C); const int Rb = Epi::PERM ? ((R & ~31) + perm32(R & 31)) : R;
        voffA[i] = (unsigned)(R * K + C) * 2u; voffB[i] = (unsigned)(Rb * K + C) * 2u; }
    const size_t kstep = (size_t)(BK * 2);
    const size_t hstep = (size_t)HALF * K * 2;
    const size_t tstep = 2 * hstep;
    const unsigned ldsw = (unsigned)wid * 1024u;
    const int aoff = lds_byte(wr * 64 + fr, fq * 8), boff = lds_byte(wc * 32 + fr, fq * 8);
#define PG8_SA(b, h) (((b) * 2 + (h)) * HTB)
#define PG8_SB(b, h) ((4 + (b) * 2 + (h)) * HTB)
#define PG8_GL(gp, ldsoff) __builtin_amdgcn_global_load_lds((const unsigned*)(gp), (PG8_LAS unsigned*)(lds + (ldsoff)), 16, 0, 0)
#define PG8_STAGE(bufoff, gbase, voff) do { _Pragma("unroll") for (int _i = 0; _i < 2; ++_i) PG8_GL((const char*)(gbase) + (voff)[_i], (bufoff) + ldsw + _i * 8192); } while (0)
#define PG8_STAGE_A(bufoff, h, kofs, nx) do { if constexpr (GATHER) { _Pragma("unroll") for (int _i = 0; _i < 2; ++_i) PG8_GL((const char*)g.A + (kofs) + vA[h][_i], (bufoff) + ldsw + _i * 8192); } \
        else { const char* _b = ((nx) ? nA : cA) + (size_t)(h) * hstep + (kofs); PG8_STAGE(bufoff, _b, voffA); } } while (0)
#define PG8_GOFF(dst, uu) do { _Pragma("unroll") for (int _h = 0; _h < 2; ++_h) _Pragma("unroll") for (int _i = 0; _i < 2; ++_i) { int _R, _C; stage_rc(tid * 16 + _i * 8192, _R, _C); \
        const int _tok = S.row_index(uu, _h * HALF + _R); dst[_h][_i] = (unsigned)(_tok * K + _C) * 2u; } } while (0)
#define PG8_LDA(dst, b, h) do { _Pragma("unroll") for (int m = 0; m < 4; ++m) _Pragma("unroll") for (int k = 0; k < 2; ++k) dst[m][k] = *(const PG8_LAS bf16x8*)(lds + PG8_SA(b, h) + aoff + m * 2048 + k * 1024); } while (0)
#define PG8_LDB(dst, b, h) do { _Pragma("unroll") for (int n = 0; n < 2; ++n) _Pragma("unroll") for (int k = 0; k < 2; ++k) dst[n][k] = *(const PG8_LAS bf16x8*)(lds + PG8_SB(b, h) + boff + n * 2048 + k * 1024); } while (0)
#define PG8_MMA(ai, bj, At, Bt) do { __builtin_amdgcn_s_setprio(1); _Pragma("unroll") for (int m = 0; m < 4; ++m) _Pragma("unroll") for (int n = 0; n < 2; ++n) _Pragma("unroll") for (int k = 0; k < 2; ++k) \
        acc[ai][bj][m][n] = __builtin_amdgcn_mfma_f32_16x16x32_bf16(Bt[n][k], At[m][k], acc[ai][bj][m][n], 0, 0, 0); __builtin_amdgcn_s_setprio(0); } while (0)
#define PG8_WAIT_V(n) asm volatile("s_waitcnt vmcnt(" #n ")" ::: "memory")
#define PG8_WAIT_L(n) asm volatile("s_waitcnt lgkmcnt(" #n ")" ::: "memory")
#define PG8_BAR __builtin_amdgcn_s_barrier()
#define PG8_SCHED __builtin_amdgcn_sched_barrier(0)
    Unit cur, nxt; int ui = 0;
    if (!S.next(0, cur)) return;
    f32x4 acc[2][2][4][2];
#pragma unroll
    for (int a = 0; a < 2; ++a)
#pragma unroll
        for (int b = 0; b < 2; ++b)
#pragma unroll
            for (int m = 0; m < 4; ++m)
#pragma unroll
                for (int n = 0; n < 2; ++n) acc[a][b][m][n] = (f32x4){0.f, 0.f, 0.f, 0.f};
    bf16x8 At[4][2], B0[2][2], B1[2][2];
    unsigned vA[2][2];
    const char* cA = (const char*)g.A + (GATHER ? (size_t)0 : (size_t)cur.pm * tstep);
    const char* cB = (const char*)g.Bt + ((size_t)cur.e * g.bexp) * 2 + (size_t)cur.pn * tstep;
    const char* nA = cA;
    if constexpr (GATHER) { PG8_GOFF(vA, cur); }
    PG8_STAGE(PG8_SB(0, 0), cB, voffB); PG8_STAGE(PG8_SB(0, 1), cB + hstep, voffB); PG8_STAGE_A(PG8_SA(0, 0), 0, 0, false); PG8_STAGE_A(PG8_SA(0, 1), 1, 0, false);
    if (wr == 1) PG8_BAR;
    PG8_WAIT_V(2); PG8_BAR;
    PG8_STAGE(PG8_SB(1, 0), cB + kstep, voffB); PG8_STAGE_A(PG8_SA(1, 0), 0, kstep, false); PG8_STAGE(PG8_SB(1, 1), cB + hstep + kstep, voffB);
    PG8_WAIT_V(6); PG8_BAR;
    for (;;) {
        const bool has_next = S.next(ui + 1, nxt);
        const char* nB = has_next ? (const char*)g.Bt + ((size_t)nxt.e * g.bexp) * 2 + (size_t)nxt.pn * tstep : cB;
        if constexpr (!GATHER) nA = has_next ? (const char*)g.A + (size_t)nxt.pm * tstep : cA;
        if constexpr (GATHER) { if (has_next) { unsigned _t[2][2]; PG8_GOFF(_t, nxt); *(PG8_LAS u32x4*)(lds + STAGE_BYTES + tid * 16) = (u32x4){_t[0][0], _t[0][1], _t[1][0], _t[1][1]}; } }
        for (int t = 0; t < nt; t += 2) {
            const bool last = (t == nt - 2);
            const size_t k1 = (size_t)(t + 1) * kstep;
            const size_t k2 = last ? (size_t)0 : (size_t)(t + 2) * kstep, k3 = k2 + kstep;
            const char* b2 = last ? nB : cB + (size_t)(t + 2) * kstep; const char* b3 = b2 + kstep;
            PG8_LDB(B0, 0, 0); PG8_LDB(B1, 0, 1); PG8_SCHED; PG8_LDA(At, 0, 0); PG8_STAGE_A(PG8_SA(1, 1), 1, k1, false);
            if constexpr (GATHER) { if (last && has_next) { const u32x4 _v = *(const PG8_LAS u32x4*)(lds + STAGE_BYTES + tid * 16); vA[0][0] = _v.x; vA[0][1] = _v.y; vA[1][0] = _v.z; vA[1][1] = _v.w; } }
            PG8_WAIT_V(8); PG8_WAIT_L(0); PG8_BAR; PG8_MMA(0, 0, At, B0); PG8_MMA(0, 1, At, B1); PG8_BAR; PG8_SCHED;
            PG8_LDA(At, 0, 1); PG8_STAGE(PG8_SB(0, 0), b2, voffB); PG8_STAGE(PG8_SB(0, 1), b2 + hstep, voffB); PG8_STAGE_A(PG8_SA(0, 0), 0, k2, last);
            PG8_WAIT_V(8); PG8_WAIT_L(0); PG8_BAR; PG8_MMA(1, 0, At, B0); PG8_MMA(1, 1, At, B1); PG8_BAR; PG8_SCHED;
            PG8_LDB(B0, 1, 0); PG8_LDB(B1, 1, 1); PG8_SCHED; PG8_LDA(At, 1, 0); PG8_STAGE_A(PG8_SA(0, 1), 1, k2, last);
            PG8_WAIT_V(8); PG8_WAIT_L(0); PG8_BAR; PG8_MMA(0, 0, At, B0); PG8_MMA(0, 1, At, B1); PG8_BAR; PG8_SCHED;
            PG8_LDA(At, 1, 1); PG8_STAGE(PG8_SB(1, 0), b3, voffB); PG8_STAGE(PG8_SB(1, 1), b3 + hstep, voffB); PG8_STAGE_A(PG8_SA(1, 0), 0, k3, last);
            PG8_WAIT_V(8); PG8_WAIT_L(0); PG8_BAR; PG8_MMA(1, 0, At, B0); PG8_MMA(1, 1, At, B1); PG8_BAR; PG8_SCHED;
        }
        if constexpr (ALIGN_EPI) { if (wr == 0) PG8_BAR; }
        E(acc, cur, wr, wc, fr, fq);
        if (!has_next) break;
#pragma unroll
        for (int a = 0; a < 2; ++a)
#pragma unroll
            for (int b = 0; b < 2; ++b)
#pragma unroll
                for (int m = 0; m < 4; ++m)
#pragma unroll
                    for (int n = 0; n < 2; ++n) acc[a][b][m][n] = (f32x4){0.f, 0.f, 0.f, 0.f};
        cur = nxt; cA = nA; cB = nB; ++ui;
        if constexpr (ALIGN_EPI) { if (wr == 1) PG8_BAR; }
    }
    PG8_WAIT_V(0);
    if constexpr (!ALIGN_EPI) { if (wr == 0) PG8_BAR; }
    PG8_BAR;
#undef PG8_SA
#undef PG8_SB
#undef PG8_GL
#undef PG8_STAGE
#undef PG8_STAGE_A
#undef PG8_GOFF
#undef PG8_LDA
#undef PG8_LDB
#undef PG8_MMA
#undef PG8_WAIT_V
#undef PG8_WAIT_L
#undef PG8_BAR
#undef PG8_SCHED
}
}

#define XB_TMO      128
#define XB_XCNT(j)  (256  + 64 * (j))
#define XB_XSUB(j)  (1280 + 64 * (j))
#define XB_XGEN(j)  (2304 + 64 * (j))
#define XB_TOP      3328
#define XB_TOPGEN   3392
#define XCD_BAR_WORDS 3456
#define XB_SPIN_CAP (1u << 18)
__device__ __forceinline__ unsigned xb_ld(unsigned* p)              { return __hip_atomic_load(p, __ATOMIC_RELAXED, __HIP_MEMORY_SCOPE_AGENT); }
__device__ __forceinline__ unsigned xb_add(unsigned* p, unsigned v) { return __hip_atomic_fetch_add(p, v, __ATOMIC_RELAXED, __HIP_MEMORY_SCOPE_AGENT); }
__device__ __forceinline__ unsigned xb_xcc_id() { return (unsigned)__builtin_amdgcn_s_getreg((3 << 11) | 20) & 0xFu; }
#define XB_SPIN(cond, bar) do { unsigned _sp = 0; while (cond) { __builtin_amdgcn_s_sleep(1); \
    if ((++_sp & 255u) == 0u) { if (xb_ld(&(bar)[XB_TMO])) break; if (_sp > XB_SPIN_CAP) { atomicAdd(&(bar)[XB_TMO], 1u); break; } } } } while (0)
struct XcdBarrier { unsigned* bar; unsigned x; volatile LAS unsigned* st; int wv; };
__device__ __forceinline__ XcdBarrier xcd_barrier_post(unsigned* bar, volatile LAS unsigned* st, int wv) {
    XcdBarrier b; b.bar = bar; b.x = xb_xcc_id(); b.st = st; b.wv = wv;
    if (wv == 0 && lane_id() == 0) (void)xb_add(&bar[XB_XCNT(b.x)], 1u);
    return b;
}
__device__ __forceinline__ void xcd_barrier_complete(unsigned* bar, unsigned x, unsigned& nloc, unsigned& nx) {
    const unsigned G = gridDim.x * gridDim.y * gridDim.z;
    unsigned sum, cnt, mine, sp = 0u;
    for (;;) {
        sum = 0u; cnt = 0u; mine = 0u;
#pragma unroll
        for (unsigned j = 0; j < 16; ++j) { const unsigned c = xb_ld(&bar[XB_XCNT(j)]); sum += c; cnt += (c > 0u) ? 1u : 0u; mine = (j == x) ? c : mine; }
        if (sum == G) break;
        __builtin_amdgcn_s_sleep(1);
        if ((++sp & 255u) == 0u) { if (xb_ld(&bar[XB_TMO])) break; if (sp > XB_SPIN_CAP) { atomicAdd(&bar[XB_TMO], 1u); break; } }
    }
    nloc = mine > 0u ? mine : 1u; nx = cnt > 0u ? cnt : 1u;
}
__device__ __forceinline__ void xcd_barrier(const XcdBarrier& b) {
    asm volatile("s_waitcnt vmcnt(0)" ::: "memory");
    __syncthreads();
    if (b.wv == 0 && lane_id() == 0) {
        unsigned* bar = b.bar;
        __builtin_amdgcn_s_waitcnt(0);
        unsigned nloc = b.st[0], nx = b.st[1];
        if (nloc == 0u) { xcd_barrier_complete(bar, b.x, nloc, nx); b.st[0] = nloc; b.st[1] = nx; }
        const unsigned old = xb_add(&bar[XB_XSUB(b.x)], 1u);
        const unsigned gen = old / nloc;
        if (old + 1u == (gen + 1u) * nloc) {
            __builtin_amdgcn_fence(__ATOMIC_RELEASE, "agent");
            asm volatile("s_waitcnt vmcnt(0)" ::: "memory");
            const unsigned og = xb_add(&bar[XB_TOP], 1u);
            const unsigned tg = og / nx;
            if (og + 1u == (tg + 1u) * nx) xb_add(&bar[XB_TOPGEN], 1u);
            else XB_SPIN(xb_ld(&bar[XB_TOPGEN]) == tg, bar);
            __builtin_amdgcn_fence(__ATOMIC_ACQUIRE, "agent");
            xb_add(&bar[XB_XGEN(b.x)], 1u);
            asm volatile("s_waitcnt vmcnt(0)" ::: "memory");
        } else {
            XB_SPIN(xb_ld(&bar[XB_XGEN(b.x)]) == gen, bar);
            __builtin_amdgcn_fence(__ATOMIC_ACQUIRE, "agent");
            asm volatile("s_waitcnt vmcnt(0)" ::: "memory");
        }
    }
    __syncthreads();
}

struct Args { const float* in[25]; float* out; unsigned char* ws; int ph_lo, ph_hi; };
typedef const __attribute__((address_space(4))) unsigned char* kseg_t;
__device__ __forceinline__ kseg_t kseg() { kseg_t p = (kseg_t)__builtin_amdgcn_kernarg_segment_ptr(); asm volatile("" : "+s"(p)); return p; }
__device__ __forceinline__ const float* karg(int i) { return *(const float* const __attribute__((address_space(4)))*)(kseg() + 8 * i); }
__device__ __forceinline__ float* kout() { return *(float* const __attribute__((address_space(4)))*)(kseg() + 8 * 25); }
__device__ __forceinline__ unsigned char* kws() { return *(unsigned char* const __attribute__((address_space(4)))*)(kseg() + 8 * 26); }
enum { I_X = 0, I_C, I_ADAW, I_ADAB, I_N1W, I_N2W, I_FNW, I_MWIN, I_MIB, I_MFB, I_MCW, I_MCB, I_MNW, I_MWOUT, I_HWIN, I_HLB, I_HNW, I_HWOUT, I_FG, I_FU, I_FD, I_RT, I_EG, I_EU, I_ED };

__device__ __forceinline__ void tr_item(const float* W, int ldw, int k0, int n0, bf16_t* WT, int ldt, int dst_row0, LAS float* scr, int lane) {
    float wv[32];
#pragma unroll
    for (int i = 0; i < 32; ++i) { const int kk = 2 * i + (lane >> 5); wv[i] = W[(size_t)(k0 + kk) * ldw + n0 + (lane & 31)]; }
#pragma unroll
    for (int i = 0; i < 32; ++i) { const int kk = 2 * i + (lane >> 5); scr[kk * 33 + (lane & 31)] = wv[i]; }
    asm volatile("s_waitcnt lgkmcnt(0)" ::: "memory");
    const int c = lane & 7;
#pragma unroll
    for (int j = 0; j < 4; ++j) { const int n = (lane >> 3) + 8 * j; const LAS float* s = scr + (8 * c) * 33 + n;
        u32x4 o; o.x = pk2(s[0 * 33], s[1 * 33]); o.y = pk2(s[2 * 33], s[3 * 33]); o.z = pk2(s[4 * 33], s[5 * 33]); o.w = pk2(s[6 * 33], s[7 * 33]);
        *(u32x4*)(WT + (size_t)(dst_row0 + n) * ldt + k0 + 8 * c) = o; }
    asm volatile("s_waitcnt lgkmcnt(0)" ::: "memory");
}
__device__ __forceinline__ void tr_matrix_item(const float* W, int K, int ldw, int ncols, bf16_t* WT, int mode, int item, LAS float* scr, int lane) {
    const int nblk = ncols / 32, kb = item / nblk, nb = item % nblk, n0 = nb * 32;
    const int dr = (mode == 0) ? n0 : (mode == 3) ? (n0 + (n0 < 1024 ? 0 : (n0 < 2048 ? 1024 : -1024))) : (mode == 4) ? (n0 + (n0 < 2048 ? 0 : (n0 < 3072 ? 1024 : -1024)))
                                     : ((n0 >> 7) * 256 + (n0 & 127) + (mode == 2 ? 128 : 0));
    tr_item(W, ldw, kb * 64, n0, WT, K, dr, scr, lane);
}
constexpr int CV_MIN = 16 * 96, CV_SQ = 16 * 32, CV_FG1 = 16 * 88, CV_FD1 = 44 * 32, CV_HIN = 16 * 128, CV_EG1 = 16 * 44, CV_ED1 = 22 * 32;
constexpr int CV_PER_LP = CV_MIN + CV_SQ + 2 * CV_FG1 + CV_FD1 + CV_HIN + CV_SQ + 8 * (2 * CV_EG1 + CV_ED1);
constexpr int CV_FIRST = CV_MIN + CV_SQ + 2 * CV_FG1 + CV_FD1;
constexpr int CV_TAIL1 = (CV_PER_LP * 2) / 5;
__device__ __forceinline__ void convert_items(LAS unsigned char* lds, int tid, int vb, int NV, int it_lo, int it_hi) {
    tid = opaque_v(tid); vb = opaque_s(vb);
    const int lane = tid & 63, wave = __builtin_amdgcn_readfirstlane(tid >> 6);
    unsigned char* ws = kws();
    LAS float* scr = (LAS float*)(lds + wave * 8448);
    constexpr int I_MIN = CV_MIN, I_SQ = CV_SQ, I_FG1 = CV_FG1, I_FD1 = CV_FD1, I_HIN = CV_HIN, I_EG1 = CV_EG1, I_ED1 = CV_ED1;
    constexpr int PER_LP = CV_PER_LP;
    const int gw = vb * 8 + wave, NGW = NV * 8;
    for (int it = it_lo + gw; it < it_hi; it += NGW) {
        const int j = it / PER_LP; int r = it % PER_LP;
        unsigned char* wb = ws + WS_WGT + (size_t)j * LP_BYTES;
        if (r < I_MIN) { tr_matrix_item(karg(I_MWIN) + (size_t)j * 1024 * MPROJ, 1024, MPROJ, MPROJ_G, (bf16_t*)(wb + W_MIN), 3, r, scr, lane); continue; } r -= I_MIN;
        if (r < I_SQ) { tr_matrix_item(karg(I_MWOUT) + (size_t)j * 1024 * 1024, 1024, 1024, 1024, (bf16_t*)(wb + W_MOUT), 0, r, scr, lane); continue; } r -= I_SQ;
        if (r < I_FG1) { tr_matrix_item(karg(I_FG) + (size_t)j * 1024 * DFF, 1024, DFF, DFF, (bf16_t*)(wb + W_FGU), 1, r, scr, lane); continue; } r -= I_FG1;
        if (r < I_FG1) { tr_matrix_item(karg(I_FU) + (size_t)j * 1024 * DFF, 1024, DFF, DFF, (bf16_t*)(wb + W_FGU), 2, r, scr, lane); continue; } r -= I_FG1;
        if (r < I_FD1) { tr_matrix_item(karg(I_FD) + (size_t)j * DFF * 1024, DFF, 1024, 1024, (bf16_t*)(wb + W_FD), 0, r, scr, lane); continue; } r -= I_FD1;
        if (r < I_HIN) { tr_matrix_item(karg(I_HWIN) + (size_t)j * 1024 * HPROJ, 1024, HPROJ, HPROJ, (bf16_t*)(wb + W_HIN), 4, r, scr, lane); continue; } r -= I_HIN;
        if (r < I_SQ) { tr_matrix_item(karg(I_HWOUT) + (size_t)j * 1024 * 1024, 1024, 1024, 1024, (bf16_t*)(wb + W_HOUT), 0, r, scr, lane); continue; } r -= I_SQ;
        const int e = r / (2 * I_EG1 + I_ED1); r -= e * (2 * I_EG1 + I_ED1);
        if (r < I_EG1) { tr_matrix_item(karg(I_EG) + ((size_t)j * 8 + e) * 1024 * DFE, 1024, DFE, DFE, (bf16_t*)(wb + W_EGU) + (size_t)e * 2816 * 1024, 1, r, scr, lane); continue; } r -= I_EG1;
        if (r < I_EG1) { tr_matrix_item(karg(I_EU) + ((size_t)j * 8 + e) * 1024 * DFE, 1024, DFE, DFE, (bf16_t*)(wb + W_EGU) + (size_t)e * 2816 * 1024, 2, r, scr, lane); continue; } r -= I_EG1;
        tr_matrix_item(karg(I_ED) + ((size_t)j * 8 + e) * DFE * 1024, DFE, 1024, 1024, (bf16_t*)(wb + W_ED) + (size_t)e * 1024 * DFE, 0, r, scr, lane);
    }
}

__device__ __forceinline__ void tail_convert(LAS unsigned char* lds, int tid, int c, int G, int nwg, int it_lo, int it_hi) {
    const int rounds = (nwg + G - 1) / G, n_last = nwg - G * (rounds - 1);
    if (n_last >= G || rounds == 0) convert_items(lds, tid, c, G, it_lo, it_hi);
    else if (c >= n_last) convert_items(lds, tid, c - n_last, G - n_last, it_lo, it_hi);
}
__device__ __forceinline__ void p0_phase(LAS unsigned char* lds, int tid, int bid, int G) {
    tid = opaque_v(tid); bid = opaque_s(bid);
    const int lane = tid & 63, wave = __builtin_amdgcn_readfirstlane(tid >> 6);
    unsigned char* ws = kws();
    LAS float* cond = (LAS float*)(lds + 69632);
    LAS float* red = (LAS float*)(lds + 102400);
    for (int i = tid; i < 8 * 1024; i += 512) cond[i] = siluf_(karg(I_C)[i]);
    __syncthreads();
    float* mod = (float*)(ws + WS_MOD);
    for (int item = bid; item < 256; item += G) {
        const int L = item >> 6, n0 = (item & 63) * 96;
        float acc[8][2];
#pragma unroll
        for (int b = 0; b < 8; ++b) { acc[b][0] = 0.f; acc[b][1] = 0.f; }
        if (lane < 48) {
            const float* wp = karg(I_ADAW) + ((size_t)L * 1024 + wave * 128) * 6144 + n0 + 2 * lane;
#pragma unroll 8
            for (int k = 0; k < 128; ++k) { const f32x2 wv = *(const f32x2*)(wp + (size_t)k * 6144);
#pragma unroll
                for (int b = 0; b < 8; ++b) { const float cv = cond[b * 1024 + wave * 128 + k]; acc[b][0] += cv * wv.x; acc[b][1] += cv * wv.y; } }
#pragma unroll
            for (int b = 0; b < 8; ++b) { red[(wave * 8 + b) * 96 + 2 * lane] = acc[b][0]; red[(wave * 8 + b) * 96 + 2 * lane + 1] = acc[b][1]; }
        }
        __syncthreads();
        for (int o = tid; o < 768; o += 512) { const int b = o / 96, n = o % 96; float s = 0.f;
#pragma unroll
            for (int w = 0; w < 8; ++w) s += red[(w * 8 + b) * 96 + n];
            mod[((size_t)L * 8 + b) * 6144 + n0 + n] = s + karg(I_ADAB)[L * 6144 + n0 + n]; }
        __syncthreads();
    }
    if (bid == 0) { float* lb = (float*)(ws + WS_LB); for (int d = tid; d < 1024; d += 512) lb[d] = sigmoidf_(karg(I_HLB)[1024 + d] - karg(I_HLB)[d]); }
    for (int i = bid * 512 + tid; i < 2 * 16 * 1024 + 2 * 8 * 1024; i += G * 512) {
        if (i < 2 * 16 * 1024) { const int j = i >> 14, g = (i >> 10) & 15, k = i & 1023;
            ((float*)(ws + WS_WGT + (size_t)j * LP_BYTES + W_MGATE))[g * 1024 + k] = karg(I_MWIN)[((size_t)j * 1024 + k) * MPROJ + MPROJ_G + g]; }
        else { const int i2 = i - 2 * 16 * 1024; const int j = i2 >> 13, e = (i2 >> 10) & 7, k = i2 & 1023;
            ((float*)(ws + WS_WGT + (size_t)j * LP_BYTES + W_ROUT))[e * 1024 + k] = karg(I_RT)[((size_t)j * 1024 + k) * 8 + e]; }
    }
    convert_items(lds, tid, bid, G, 0, CV_PER_LP);
}

template <int MODE, bool COMBINE, bool XF32 = false>
__device__ __forceinline__ void norm_phase(LAS unsigned char* lds, int tid, int bid, int G, const void* xsrc, bf16_t* xdst, const bf16_t* Y,
                                           const float* normw, const float* shift, const float* scale, bf16_t* hn,
                                           const float* Wx  , const float* ibias, const float* fbias, float* li, float* lf,
                                           unsigned* gcnt, int* lst_tok, float* lst_w) {
    tid = opaque_v(tid); bid = opaque_s(bid);
    const int lane = tid & 63, wave = __builtin_amdgcn_readfirstlane(tid >> 6);
    constexpr int NX = (MODE == 1) ? 16 : 8;
    LAS float* wl = (LAS float*)lds;
    LAS unsigned* lcnt = (LAS unsigned*)(lds + 65536);
    LAS unsigned* gbase = (LAS unsigned*)(lds + 65536 + 64);
    LAS int* rinfo = (LAS int*)(lds + 65536 + 128);
    if (MODE != 0) { for (int i = tid; i < NX * 1024; i += 512) { const int g = i >> 10, r = i & 1023, m = r >> 8, ln = (r >> 2) & 63, e = r & 3; wl[i] = Wx[g * 1024 + 8 * ln + 512 * (m >> 1) + 4 * (m & 1) + e]; } }
    __syncthreads();
    for (int blk = bid; blk < T / 128; blk += G) {
        const int b = blk >> 5;
        f32x4 gw[4], sh[4];
#pragma unroll
        for (int j = 0; j < 4; ++j) { const int col = 8 * lane + 512 * (j >> 1) + 4 * (j & 1); const f32x4 w = *(const f32x4*)(normw + col), sc = *(const f32x4*)(scale + (size_t)b * 6144 + col);
            gw[j] = w * (1.f + sc); sh[j] = *(const f32x4*)(shift + (size_t)b * 6144 + col); }
        if (MODE == 2) { if (tid < 8) lcnt[tid] = 0u; __syncthreads(); }
        f32x4 pxf[4]; u32x4 pxb[2], py0[2], py1[2];
#define NP_LOAD(rw) do { \
            if (XF32) { _Pragma("unroll") for (int j = 0; j < 4; ++j) pxf[j] = *(const f32x4*)((const float*)xsrc + (rw) * D + 8 * lane + 512 * (j >> 1) + 4 * (j & 1)); } \
            else { _Pragma("unroll") for (int jj = 0; jj < 2; ++jj) pxb[jj] = *(const u32x4*)((const bf16_t*)xsrc + (rw) * XP + 8 * lane + 512 * jj); } \
            if (COMBINE) { _Pragma("unroll") for (int jj = 0; jj < 2; ++jj) { py0[jj] = *(const u32x4*)(Y + ((rw) * 2) * D + 8 * lane + 512 * jj); py1[jj] = *(const u32x4*)(Y + ((rw) * 2 + 1) * D + 8 * lane + 512 * jj); } } } while (0)
        NP_LOAD((size_t)blk * 128 + wave * 16);
        f32x4 vp[4];
        for (int i = 0; i < 16; ++i) {
            const int rl = wave * 16 + i; const size_t row = (size_t)blk * 128 + rl;
            f32x4 v[4]; float s = 0.f; u32x4 cy0[2], cy1[2];
            if (XF32) {
#pragma unroll
                for (int j = 0; j < 4; ++j) v[j] = pxf[j];
            } else {
#pragma unroll
                for (int jj = 0; jj < 2; ++jj) { v[2 * jj] = (f32x4){bf2f_lo(pxb[jj].x), bf2f_hi(pxb[jj].x), bf2f_lo(pxb[jj].y), bf2f_hi(pxb[jj].y)}; v[2 * jj + 1] = (f32x4){bf2f_lo(pxb[jj].z), bf2f_hi(pxb[jj].z), bf2f_lo(pxb[jj].w), bf2f_hi(pxb[jj].w)}; }
            }
            if (COMBINE) {
#pragma unroll
                for (int jj = 0; jj < 2; ++jj) { cy0[jj] = py0[jj]; cy1[jj] = py1[jj]; }
            }
            { const size_t rn = (size_t)blk * 128 + wave * 16 + (i < 15 ? i + 1 : i); NP_LOAD(rn); }
            if (COMBINE) {
#pragma unroll
                for (int jj = 0; jj < 2; ++jj) { const u32x4 y0 = cy0[jj], y1 = cy1[jj];
                    v[2 * jj].x += bf2f_lo(y0.x) + bf2f_lo(y1.x); v[2 * jj].y += bf2f_hi(y0.x) + bf2f_hi(y1.x); v[2 * jj].z += bf2f_lo(y0.y) + bf2f_lo(y1.y); v[2 * jj].w += bf2f_hi(y0.y) + bf2f_hi(y1.y);
                    v[2 * jj + 1].x += bf2f_lo(y0.z) + bf2f_lo(y1.z); v[2 * jj + 1].y += bf2f_hi(y0.z) + bf2f_hi(y1.z); v[2 * jj + 1].z += bf2f_lo(y0.w) + bf2f_lo(y1.w); v[2 * jj + 1].w += bf2f_hi(y0.w) + bf2f_hi(y1.w);
                    u32x4 xo4; xo4.x = pk2(v[2 * jj].x, v[2 * jj].y); xo4.y = pk2(v[2 * jj].z, v[2 * jj].w); xo4.z = pk2(v[2 * jj + 1].x, v[2 * jj + 1].y); xo4.w = pk2(v[2 * jj + 1].z, v[2 * jj + 1].w);
                    *(u32x4*)(xdst + row * XP + 8 * lane + 512 * jj) = xo4; }
            }
#pragma unroll
            for (int j = 0; j < 4; ++j) s += (v[j].x * v[j].x + v[j].y * v[j].y) + (v[j].z * v[j].z + v[j].w * v[j].w);
            const float rstd = rsqrtf(wave_sum(s) * (1.f / D) + EPS);
#pragma unroll
            for (int j = 0; j < 4; ++j) v[j] = v[j] * rstd * gw[j] + sh[j];
#pragma unroll
            for (int jj = 0; jj < 2; ++jj) { u32x4 o; o.x = pk2(v[2 * jj].x, v[2 * jj].y); o.y = pk2(v[2 * jj].z, v[2 * jj].w); o.z = pk2(v[2 * jj + 1].x, v[2 * jj + 1].y); o.w = pk2(v[2 * jj + 1].z, v[2 * jj + 1].w);
                *(u32x4*)(hn + row * D + 8 * lane + 512 * jj) = o; }
            if (MODE != 0) {
                if ((i & 1) == 0) {
#pragma unroll
                    for (int j = 0; j < 4; ++j) vp[j] = v[j];
                } else {
                    float pa[NX], pb[NX];
#pragma unroll
                    for (int g = 0; g < NX; ++g) { f32x2 a0 = (f32x2){0.f, 0.f}, a1 = a0;
#pragma unroll
                        for (int j = 0; j < 4; ++j) { const f32x4 w = *(const LAS f32x4*)(wl + g * 1024 + 4 * lane + 256 * j); const f32x2 wlo = (f32x2){w.x, w.y}, whi = (f32x2){w.z, w.w};
                            a0 = a0 + (f32x2){vp[j].x, vp[j].y} * wlo; a0 = a0 + (f32x2){vp[j].z, vp[j].w} * whi;
                            a1 = a1 + (f32x2){v[j].x, v[j].y} * wlo; a1 = a1 + (f32x2){v[j].z, v[j].w} * whi; }
                        pa[g] = a0.x + a0.y; pb[g] = a1.x + a1.y; }
                    const bool b5 = (lane & 32) != 0, b4 = (lane & 16) != 0, b3 = (lane & 8) != 0, b2 = (lane & 4) != 0;
                    float ra, rb;
                    if (NX == 16) {
                        float qa[8], qb[8];
#pragma unroll
                        for (int k = 0; k < 8; ++k) { qa[k] = (b5 ? pa[8 + k] : pa[k]) + __shfl_xor(b5 ? pa[k] : pa[8 + k], 32); qb[k] = (b5 ? pb[8 + k] : pb[k]) + __shfl_xor(b5 ? pb[k] : pb[8 + k], 32); }
                        float ta[4], tb[4];
#pragma unroll
                        for (int k = 0; k < 4; ++k) { ta[k] = (b4 ? qa[4 + k] : qa[k]) + __shfl_xor(b4 ? qa[k] : qa[4 + k], 16); tb[k] = (b4 ? qb[4 + k] : qb[k]) + __shfl_xor(b4 ? qb[k] : qb[4 + k], 16); }
                        float ua[2], ub[2];
#pragma unroll
                        for (int k = 0; k < 2; ++k) { ua[k] = (b3 ? ta[2 + k] : ta[k]) + __shfl_xor(b3 ? ta[k] : ta[2 + k], 8); ub[k] = (b3 ? tb[2 + k] : tb[k]) + __shfl_xor(b3 ? tb[k] : tb[2 + k], 8); }
                        ra = (b2 ? ua[1] : ua[0]) + __shfl_xor(b2 ? ua[0] : ua[1], 4); rb = (b2 ? ub[1] : ub[0]) + __shfl_xor(b2 ? ub[0] : ub[1], 4);
                        ra += __shfl_xor(ra, 2); rb += __shfl_xor(rb, 2); ra += __shfl_xor(ra, 1); rb += __shfl_xor(rb, 1);
                    } else {
                        float ta[4], tb[4];
#pragma unroll
                        for (int k = 0; k < 4; ++k) { ta[k] = (b5 ? pa[4 + k] : pa[k]) + __shfl_xor(b5 ? pa[k] : pa[4 + k], 32); tb[k] = (b5 ? pb[4 + k] : pb[k]) + __shfl_xor(b5 ? pb[k] : pb[4 + k], 32); }
                        float ua[2], ub[2];
#pragma unroll
                        for (int k = 0; k < 2; ++k) { ua[k] = (b4 ? ta[2 + k] : ta[k]) + __shfl_xor(b4 ? ta[k] : ta[2 + k], 16); ub[k] = (b4 ? tb[2 + k] : tb[k]) + __shfl_xor(b4 ? tb[k] : tb[2 + k], 16); }
                        ra = (b3 ? ua[1] : ua[0]) + __shfl_xor(b3 ? ua[0] : ua[1], 8); rb = (b3 ? ub[1] : ub[0]) + __shfl_xor(b3 ? ub[0] : ub[1], 8);
                        ra += __shfl_xor(ra, 4); rb += __shfl_xor(rb, 4); ra += __shfl_xor(ra, 2); rb += __shfl_xor(rb, 2); ra += __shfl_xor(ra, 1); rb += __shfl_xor(rb, 1);
                    }
                    if (MODE == 1) {
                        if ((lane & 3) == 0) { const int g = lane >> 2;
#pragma unroll
                            for (int q = 0; q < 2; ++q) { const size_t rw = row - 1 + q; const float sum = q ? rb : ra;
                                if (g < 8) { const float a = sum + ibias[g]; li[rw * 8 + g] = 15.f * tanhf(a * (1.f / 15.f)); }
                                else { const float a = sum + fbias[g - 8]; lf[rw * 8 + g - 8] = fminf(a, 0.f) - log1pf(expf(-fabsf(a))); } } }
                    }
                    if (MODE == 2) {
#pragma unroll
                        for (int q = 0; q < 2; ++q) { const float rr = q ? rb : ra;
                            float lg[8];
#pragma unroll
                            for (int e = 0; e < 8; ++e) lg[e] = __builtin_bit_cast(float, __builtin_amdgcn_readlane(__builtin_bit_cast(int, rr), 8 * e));
                            int e0 = 0; float m0 = lg[0];
#pragma unroll
                            for (int e = 1; e < 8; ++e) if (lg[e] > m0) { m0 = lg[e]; e0 = e; }
                            int e1 = -1; float m1 = -3.0e38f;
#pragma unroll
                            for (int e = 0; e < 8; ++e) if (e != e0 && lg[e] > m1) { m1 = lg[e]; e1 = e; }
                            if (lane == 0) { const float w0 = 1.f / (1.f + __expf(m1 - m0)), w1 = 1.f - w0;
                                const unsigned p0 = __hip_atomic_fetch_add(lcnt + e0, 1u, __ATOMIC_RELAXED, __HIP_MEMORY_SCOPE_WORKGROUP), p1 = __hip_atomic_fetch_add(lcnt + e1, 1u, __ATOMIC_RELAXED, __HIP_MEMORY_SCOPE_WORKGROUP);
                                LAS int* ri = rinfo + (rl - 1 + q) * 6; ri[0] = e0; ri[1] = (int)p0; ri[2] = __builtin_bit_cast(int, w0); ri[3] = e1; ri[4] = (int)p1; ri[5] = __builtin_bit_cast(int, w1); } }
                    }
                }
            }
        }
        if (MODE == 2) {
            __syncthreads();
            if (tid < 8) gbase[tid] = __hip_atomic_fetch_add(gcnt + tid, lcnt[tid], __ATOMIC_RELAXED, __HIP_MEMORY_SCOPE_AGENT);
            __syncthreads();
            if (tid < 128) { const LAS int* ri = rinfo + tid * 6; const int tok = blk * 128 + tid;
                const int e0 = ri[0], e1 = ri[3]; const size_t q0 = (size_t)e0 * T + gbase[e0] + ri[1], q1 = (size_t)e1 * T + gbase[e1] + ri[4];
                lst_tok[q0] = tok * 2; lst_w[q0] = __builtin_bit_cast(float, ri[2]); lst_tok[q1] = tok * 2 + 1; lst_w[q1] = __builtin_bit_cast(float, ri[5]); }
            __syncthreads();
        }
    }
}
#undef NP_LOAD
template <bool COMBINE>
__device__ __forceinline__ void final_phase(int tid, int bid, int G, float* x, const bf16_t* Y, const float* fw) {
    tid = opaque_v(tid); bid = opaque_s(bid);
    const int lane = tid & 63, wave = tid >> 6;
    f32x4 w4[4];
#pragma unroll
    for (int j = 0; j < 4; ++j) w4[j] = *(const f32x4*)(fw + 8 * lane + 512 * (j >> 1) + 4 * (j & 1));
    u32x4 pxb[2], py0[2], py1[2];
#define FP_LOAD(rw) do { _Pragma("unroll") for (int jj = 0; jj < 2; ++jj) { pxb[jj] = *(const u32x4*)((const bf16_t*)x + (rw) * XP + 8 * lane + 512 * jj); \
        if (COMBINE) { py0[jj] = *(const u32x4*)(Y + ((rw) * 2) * D + 8 * lane + 512 * jj); py1[jj] = *(const u32x4*)(Y + ((rw) * 2 + 1) * D + 8 * lane + 512 * jj); } } } while (0)
    { const size_t r0 = (size_t)bid * 8 + wave; FP_LOAD((r0 < (size_t)T ? r0 : (size_t)0)); }
    for (size_t row = (size_t)bid * 8 + wave; row < (size_t)T; row += (size_t)G * 8) {
        f32x4 v[4]; float s = 0.f; u32x4 cy0[2], cy1[2];
#pragma unroll
        for (int jj = 0; jj < 2; ++jj) { v[2 * jj] = (f32x4){bf2f_lo(pxb[jj].x), bf2f_hi(pxb[jj].x), bf2f_lo(pxb[jj].y), bf2f_hi(pxb[jj].y)}; v[2 * jj + 1] = (f32x4){bf2f_lo(pxb[jj].z), bf2f_hi(pxb[jj].z), bf2f_lo(pxb[jj].w), bf2f_hi(pxb[jj].w)};
            if (COMBINE) { cy0[jj] = py0[jj]; cy1[jj] = py1[jj]; } }
        { const size_t rn = row + (size_t)G * 8; FP_LOAD((rn < (size_t)T ? rn : row)); }
        if (COMBINE) {
#pragma unroll
            for (int jj = 0; jj < 2; ++jj) { const u32x4 y0 = cy0[jj], y1 = cy1[jj];
                v[2 * jj].x += bf2f_lo(y0.x) + bf2f_lo(y1.x); v[2 * jj].y += bf2f_hi(y0.x) + bf2f_hi(y1.x); v[2 * jj].z += bf2f_lo(y0.y) + bf2f_lo(y1.y); v[2 * jj].w += bf2f_hi(y0.y) + bf2f_hi(y1.y);
                v[2 * jj + 1].x += bf2f_lo(y0.z) + bf2f_lo(y1.z); v[2 * jj + 1].y += bf2f_hi(y0.z) + bf2f_hi(y1.z); v[2 * jj + 1].z += bf2f_lo(y0.w) + bf2f_lo(y1.w); v[2 * jj + 1].w += bf2f_hi(y0.w) + bf2f_hi(y1.w); }
        }
#pragma unroll
        for (int j = 0; j < 4; ++j) s += (v[j].x * v[j].x + v[j].y * v[j].y) + (v[j].z * v[j].z + v[j].w * v[j].w);
        const float rstd = rsqrtf(wave_sum(s) * (1.f / D) + EPS);
#pragma unroll
        for (int j = 0; j < 4; ++j) *(f32x4*)(x + row * D + 8 * lane + 512 * (j >> 1) + 4 * (j & 1)) = v[j] * rstd * w4[j];
    }
#undef FP_LOAD
}

#define MK_DPP_F(idv, v, ctrl, rmask) __builtin_bit_cast(float, __builtin_amdgcn_update_dpp(__builtin_bit_cast(int, (float)(idv)), __builtin_bit_cast(int, (float)(v)), (ctrl), (rmask), 0xf, false))
__device__ __forceinline__ float wave_scan_add(float v) {
    v += MK_DPP_F(0.f, v, 0x111, 0xf); v += MK_DPP_F(0.f, v, 0x112, 0xf); v += MK_DPP_F(0.f, v, 0x114, 0xf); v += MK_DPP_F(0.f, v, 0x118, 0xf);
    v += MK_DPP_F(0.f, v, 0x142, 0xa); v += MK_DPP_F(0.f, v, 0x143, 0xc);
    return v;
}
__device__ __forceinline__ float wave_scan_max(float v) {
    constexpr float NI = -3.0e38f;
    v = fmaxf(v, MK_DPP_F(NI, v, 0x111, 0xf)); v = fmaxf(v, MK_DPP_F(NI, v, 0x112, 0xf)); v = fmaxf(v, MK_DPP_F(NI, v, 0x114, 0xf)); v = fmaxf(v, MK_DPP_F(NI, v, 0x118, 0xf));
    v = fmaxf(v, MK_DPP_F(NI, v, 0x142, 0xa)); v = fmaxf(v, MK_DPP_F(NI, v, 0x143, 0xc));
    return v;
}
struct MpPf { u32x4 pq, pk, phq, phk; f32x4 pg4; };
__device__ __forceinline__ void mp_load(MpPf& P, int itx, int tid, int lane, const bf16_t* QKR, const bf16_t* OGT, const bf16_t* VTT, const float* LIb, const float* LFb) {
    const int b_ = itx >> 9, h_ = (itx >> 6) & 7, c_ = itx & 63; const size_t m0_ = (size_t)b_ * SEQ + (size_t)c_ * 64; const size_t ib_ = (size_t)itx * 8192 + tid * 8;
    P.pq = *(const u32x4*)(QKR + ib_); P.pk = *(const u32x4*)(QKR + ib_ + 4096);
    { const size_t hb_ = (itx > 0 ? ib_ - 8192 : ib_) + (size_t)(tid < 24 ? 61 * 64 : 0); P.phq = *(const u32x4*)(QKR + hb_); P.phk = *(const u32x4*)(QKR + hb_ + 4096);
      if (c_ == 0) { P.phq = (u32x4){0u, 0u, 0u, 0u}; P.phk = P.phq; } }
    { const float* gp_ = (tid < 64) ? LIb : LFb; P.pg4 = *(const f32x4*)(gp_ + (m0_ + (tid & 63)) * 8 + 4 * (h_ >> 2)); }
}
__device__ __forceinline__ void mlstm_prep(LAS unsigned char* lds, int tid, int bid, int G, const bf16_t* QKR, bf16_t* OGT, const bf16_t* VTT, const float* LIb, const float* LFb, f32x4* SCT, f32x4* SCI,
                                           const float* convw, const float* convb, const float* normw, bf16_t* QKT, bf16_t* U) {
    tid = opaque_v(tid); bid = opaque_s(bid);
    const int lane = tid & 63, w = __builtin_amdgcn_readfirstlane(tid >> 6), l15 = lane & 15, q4 = lane >> 4;
    LAS bf16_t* QR = (LAS bf16_t*)(lds + 0);
    LAS bf16_t* KR = (LAS bf16_t*)(lds + 8704);
    LAS bf16_t* Qc = (LAS bf16_t*)(lds + 17408);
    LAS bf16_t* Kc = (LAS bf16_t*)(lds + 26624);
    LAS bf16_t* KT = (LAS bf16_t*)(lds + 35840);
    LAS bf16_t* VT = (LAS bf16_t*)(lds + 45056);
    LAS bf16_t* Sm = (LAS bf16_t*)(lds + 63488);
    LAS float* fs = (LAS float*)(lds + 72704);
    LAS float *liv = fs, *lfv = fs + 64, *av = fs + 128, *pmx = fs + 192, *rsp = fs + 256  , *knp = fs + 384  , *bcs = fs + 896  ;
    const int pr = tid >> 3, pp = tid & 7;
    LAS float* cvt = (LAS float*)(lds + 76544);
    for (int i = tid; i < 8 * 640; i += 512) { const int h_ = i / 640, r_ = i % 640; cvt[i] = (r_ < 512) ? convw[((r_ >> 6) & 3) * 1024 + (r_ >> 8) * 512 + h_ * 64 + (r_ & 63)] : convb[((r_ - 512) >> 6) * 512 + h_ * 64 + (r_ & 63)]; }
    __syncthreads();
    MpPf PA, PB;
    if (bid < 4096) { mp_load(PA, bid, tid, lane, QKR, OGT, VTT, LIb, LFb); mp_load(PB, (bid + G < 4096) ? bid + G : bid, tid, lane, QKR, OGT, VTT, LIb, LFb); }
#define MP_STEP(P, it) do { \
        const int b = it >> 9, h = (it >> 6) & 7, c = it & 63; const size_t m0 = (size_t)b * SEQ + (size_t)c * 64; \
        *(LAS u32x4*)(QR + (3 + pr) * 64 + 8 * pp) = P.pq; *(LAS u32x4*)(KR + (3 + pr) * 64 + 8 * pp) = P.pk; \
        if (tid < 24) { *(LAS u32x4*)(QR + pr * 64 + 8 * pp) = P.phq; *(LAS u32x4*)(KR + pr * 64 + 8 * pp) = P.phk; } \
        { const float pgv = ((h & 3) == 0) ? P.pg4[0] : ((h & 3) == 1) ? P.pg4[1] : ((h & 3) == 2) ? P.pg4[2] : P.pg4[3]; if (tid < 64) liv[tid] = pgv; else if (tid < 128) lfv[tid - 64] = pgv; } \
        float wq[4], wk4[4]; const float bq = cvt[h * 640 + 512 + lane], bk = cvt[h * 640 + 576 + lane]; \
        _Pragma("unroll") \
        for (int j = 0; j < 4; ++j) { wq[j] = cvt[h * 640 + j * 64 + lane]; wk4[j] = cvt[h * 640 + 256 + j * 64 + lane]; } \
        __syncthreads(); \
        { const int itn_ = (it + 2 * G < 4096) ? it + 2 * G : it; mp_load(P, itn_, tid, lane, QKR, OGT, VTT, LIb, LFb); } \
        if (w == 0) { \
            const float bsum = wave_scan_add(lfv[lane]); \
            const float a = liv[lane] - bsum; const float pm = wave_scan_max(a); \
            av[lane] = a; pmx[lane] = pm; bcs[lane] = bsum; \
        } \
        float kk8[8]; \
        { float xq[11], xk[11]; \
        _Pragma("unroll") \
          for (int r = 0; r < 11; ++r) { xq[r] = bf2f(QR[(8 * w + r) * 64 + lane]); xk[r] = bf2f(KR[(8 * w + r) * 64 + lane]); } \
        _Pragma("unroll") \
          for (int e = 0; e < 8; ++e) { float aq = bq, ak = bk; \
        _Pragma("unroll") \
              for (int j = 0; j < 4; ++j) { aq += wq[j] * xq[e + j]; ak += wk4[j] * xk[e + j]; } \
              aq = siluf_(aq); kk8[e] = siluf_(ak) * 0.125f; \
              Qc[(8 * w + e) * 72 + lane] = (bf16_t)f2bf(aq); Kc[(8 * w + e) * 72 + lane] = (bf16_t)f2bf(kk8[e]); } } \
        __syncthreads(); \
        { const float pm63 = pmx[63]; float ksum = 0.f; float kt[8]; \
        _Pragma("unroll") \
          for (int e = 0; e < 8; ++e) { kt[e] = kk8[e] * __expf(av[8 * w + e] - pm63); ksum += kt[e]; } \
          u32x4 o; o.x = pk2(kt[0], kt[1]); o.y = pk2(kt[2], kt[3]); o.z = pk2(kt[4], kt[5]); o.w = pk2(kt[6], kt[7]); \
          *(LAS u32x4*)(KT + lane * 72 + 8 * w) = o; knp[w * 64 + lane] = ksum; } \
        { const int ti = w >> 1; float psum = 0.f; \
        _Pragma("unroll") \
          for (int jj = 0; jj < 2; ++jj) { const int tj = 2 * (w & 1) + jj; const int t = 16 * ti + l15; \
              if (tj > ti) { *(LAS u32x2*)(Sm + t * 72 + 16 * tj + 4 * q4) = (u32x2){0u, 0u}; } \
              else { f32x4 acc = (f32x4){0.f, 0.f, 0.f, 0.f}; \
        _Pragma("unroll") \
                  for (int kk = 0; kk < 2; ++kk) { const bf16x8 a = *(const LAS bf16x8*)(Kc + (16 * tj + l15) * 72 + 32 * kk + 8 * q4), bq8 = *(const LAS bf16x8*)(Qc + (16 * ti + l15) * 72 + 32 * kk + 8 * q4); \
                      acc = MFMA16(a, bq8, acc); } \
                  const float pt = pmx[t]; const f32x4 a4 = *(const LAS f32x4*)(av + 16 * tj + 4 * q4); float vv[4]; float p = 0.f; \
        _Pragma("unroll") \
                  for (int r = 0; r < 4; ++r) { const int s = 16 * tj + 4 * q4 + r; vv[r] = (s <= t) ? acc[r] * __expf(a4[r] - pt) : 0.f; p += vv[r]; } \
                  u32x2 o; o.x = pk2(vv[0], vv[1]); o.y = pk2(vv[2], vv[3]); *(LAS u32x2*)(Sm + t * 72 + 16 * tj + 4 * q4) = o; \
                  psum += p; } } \
          psum += __shfl_xor(psum, 16); psum += __shfl_xor(psum, 32); \
          if (lane < 16) rsp[(w & 1) * 64 + 16 * ti + lane] = psum; } \
        __syncthreads(); \
        *(u32x4*)(U + (size_t)it * 4096 + tid * 8) = *(const LAS u32x4*)(Sm + pr * 72 + 8 * pp); \
        if (tid < 64) { SCT[(size_t)it * 64 + tid] = (f32x4){bcs[tid], pmx[tid], rsp[tid] + rsp[64 + tid], 0.f}; \
            const float kn = ((knp[tid] + knp[64 + tid]) + (knp[128 + tid] + knp[192 + tid])) + ((knp[256 + tid] + knp[320 + tid]) + (knp[384 + tid] + knp[448 + tid])); \
            SCI[(size_t)it * 64 + tid] = (f32x4){kn, pmx[63], bcs[63], 0.f}; } \
        *(u32x4*)(QKT + (size_t)it * 8192 + tid * 8) = *(const LAS u32x4*)(Qc + pr * 72 + 8 * pp); \
        *(u32x4*)(QKT + (size_t)it * 8192 + 4096 + tid * 8) = *(const LAS u32x4*)(KT + pr * 72 + 8 * pp); \
    } while (0)
    for (int it0 = bid; it0 < 4096; it0 += 2 * G) { MP_STEP(PA, it0); if (it0 + G < 4096) MP_STEP(PB, (it0 + G)); }
#undef MP_STEP
}

struct MsPf { u32x4 pq, pk, pv0, pv1, psm; u32x2 po; f32x4 pst, psi; };
__device__ __forceinline__ void ms_load(MsPf& P, int it_, int qd, int tid, int lane, int w, int l15, int q4, const bf16_t* OGT, const bf16_t* VTT, const f32x4* SCT, const f32x4* SCI, const bf16_t* QKT, const bf16_t* U) {
    const size_t ib = (size_t)it_ * 8192 + tid * 8;
    P.pq = *(const u32x4*)(QKT + (size_t)it_ * 8192 + (16 * qd) * 64 + (tid & 127) * 8);
    P.pk = *(const u32x4*)(QKT + ib + 4096); P.pv0 = *(const u32x4*)(VTT + ib); P.pv1 = *(const u32x4*)(VTT + ib + 4096);
    P.psm = *(const u32x4*)(U + (size_t)it_ * 4096 + (16 * qd) * 64 + (tid & 127) * 8);
    P.po = *(const u32x2*)(OGT + (size_t)it_ * 8192 + (16 * qd + l15) * 128 + 16 * w + 4 * q4);
    P.pst = SCT[(size_t)it_ * 64 + 16 * qd + l15]; P.psi = SCI[(size_t)it_ * 64 + lane];
}
__device__ __forceinline__ void mlstm_scan(LAS unsigned char* lds, int tid, int bid, int G, const bf16_t* OGT, const bf16_t* VTT, const f32x4* SCT, const f32x4* SCI,
                                           const bf16_t* QKT, const bf16_t* U, bf16_t* hh) {
    tid = opaque_v(tid); bid = opaque_s(bid);
    const int lane = tid & 63, w = __builtin_amdgcn_readfirstlane(tid >> 6), l15 = lane & 15, q4 = lane >> 4;
    LAS bf16_t* Qc = (LAS bf16_t*)(lds + 0);
    LAS bf16_t* KT = (LAS bf16_t*)(lds + 9216);
    LAS bf16_t* VT = (LAS bf16_t*)(lds + 18432);
    LAS bf16_t* CT = (LAS bf16_t*)(lds + 36864);
    LAS float* ssqp = (LAS float*)(lds + 57600);
    LAS bf16_t* Sq = (LAS bf16_t*)(lds + 58368);
    const int pr = tid >> 3, pp = tid & 7;
    for (int v = bid; v < 256; v += G) {
        const int qd = (v >> 3) & 3, unit = (v & 7) + 8 * (v >> 5);
        const int b = unit >> 3, h = unit & 7; const size_t mb = (size_t)b * SEQ; const int item0 = unit * 64;
        __syncthreads();
        for (int i = tid; i < 144 * 72 / 2; i += 512) ((LAS unsigned*)CT)[i] = 0u;
        f32x4 Cacc[4];
#pragma unroll
        for (int i = 0; i < 4; ++i) Cacc[i] = (f32x4){0.f, 0.f, 0.f, 0.f};
        float m_st = 0.f, nst = 0.f;
        MsPf PA, PB;
        ms_load(PA, item0, qd, tid, lane, w, l15, q4, OGT, VTT, SCT, SCI, QKT, U);
        ms_load(PB, item0 + 1, qd, tid, lane, w, l15, q4, OGT, VTT, SCT, SCI, QKT, U);
#define MS_STEP(P, cc) do { const size_t m0 = mb + (size_t)(cc) * 64 + 16 * qd; \
            if (tid < 128) { *(LAS u32x4*)(Qc + pr * 72 + 8 * pp) = P.pq; *(LAS u32x4*)(Sq + pr * 72 + 8 * pp) = P.psm; } \
            *(LAS u32x4*)(KT + pr * 72 + 8 * pp) = P.pk; *(LAS u32x4*)(VT + pr * 72 + 8 * pp) = P.pv0; *(LAS u32x4*)(VT + (64 + pr) * 72 + 8 * pp) = P.pv1; \
            const u32x2 og = P.po; const float bt = P.pst[0], pmt = P.pst[1], rst = P.pst[2], knv = P.psi[0], pm63 = P.psi[1], b63 = P.psi[2]; \
            __syncthreads(); \
            { const int cn = ((cc) + 2 < 64) ? (cc) + 2 : 63; ms_load(P, item0 + cn, qd, tid, lane, w, l15, q4, OGT, VTT, SCT, SCI, QKT, U); } \
            bf16x8 cf[2], cnf[2], vf[2], qf[2], smf[2], kf[4][2]; \
            _Pragma("unroll") for (int kk = 0; kk < 2; ++kk) { cf[kk] = *(const LAS bf16x8*)(CT + (16 * w + l15) * 72 + 32 * kk + 8 * q4); cnf[kk] = *(const LAS bf16x8*)(CT + (128 + l15) * 72 + 32 * kk + 8 * q4); \
                vf[kk] = *(const LAS bf16x8*)(VT + (16 * w + l15) * 72 + 32 * kk + 8 * q4); qf[kk] = *(const LAS bf16x8*)(Qc + l15 * 72 + 32 * kk + 8 * q4); smf[kk] = *(const LAS bf16x8*)(Sq + l15 * 72 + 32 * kk + 8 * q4); \
                _Pragma("unroll") for (int ti = 0; ti < 4; ++ti) kf[ti][kk] = *(const LAS bf16x8*)(KT + (16 * ti + l15) * 72 + 32 * kk + 8 * q4); } \
            f32x4 acc = (f32x4){0.f, 0.f, 0.f, 0.f}, accn = acc, u4 = acc, tmp[4]; \
            _Pragma("unroll") for (int kk = 0; kk < 2; ++kk) { acc = MFMA16(cf[kk], qf[kk], acc); accn = MFMA16(cnf[kk], qf[kk], accn); u4 = MFMA16(vf[kk], smf[kk], u4); } \
            _Pragma("unroll") for (int ti = 0; ti < 4; ++ti) { tmp[ti] = (f32x4){0.f, 0.f, 0.f, 0.f}; \
                _Pragma("unroll") for (int kk = 0; kk < 2; ++kk) tmp[ti] = MFMA16(kf[ti][kk], vf[kk], tmp[ti]); } \
            const float M63 = fmaxf(m_st, pm63), decay = __expf(m_st - M63), rho = __expf(pm63 - M63); \
            const float qn = accn[0]; \
            const float Mt = fmaxf(m_st, pmt), wt = __expf(m_st - Mt), rt = __expf(pmt - Mt); \
            const float den = wt * qn + rt * rst; const float dd = fmaxf(fabsf(den), __expf(-(bt + Mt))); \
            const f32x4 hv = (acc * wt + u4 * rt) * __builtin_amdgcn_rcpf(dd); \
            { const float p = rows4_sum((hv[0] * hv[0] + hv[1] * hv[1]) + (hv[2] * hv[2] + hv[3] * hv[3])); if (lane < 16) ssqp[lane * 8 + w] = p; } \
            _Pragma("unroll") for (int ti = 0; ti < 4; ++ti) Cacc[ti] = Cacc[ti] * decay + tmp[ti] * rho; \
            nst = nst * decay + knv * rho; \
            m_st = b63 + M63; \
            __syncthreads(); \
            _Pragma("unroll") for (int ti = 0; ti < 4; ++ti) { u32x2 o; o.x = pk2(Cacc[ti][0], Cacc[ti][1]); o.y = pk2(Cacc[ti][2], Cacc[ti][3]); *(LAS u32x2*)(CT + (16 * w + l15) * 72 + 16 * ti + 4 * q4) = o; } \
            if (w < 4) CT[(128 + 4 * w) * 72 + lane] = (bf16_t)f2bf(nst); \
            { const f32x4 s0 = *(const LAS f32x4*)(ssqp + l15 * 8), s1 = *(const LAS f32x4*)(ssqp + l15 * 8 + 4); \
              const float ssum = ((s0[0] + s0[1]) + (s0[2] + s0[3])) + ((s1[0] + s1[1]) + (s1[2] + s1[3])); \
              const float rstd = rsqrtf(ssum * (1.f / 128.f) + EPS); \
              u32x2 o; o.x = pk2(hv[0] * rstd * bf2f_lo(og.x), hv[1] * rstd * bf2f_hi(og.x)); o.y = pk2(hv[2] * rstd * bf2f_lo(og.y), hv[3] * rstd * bf2f_hi(og.y)); \
              *(u32x2*)(hh + (m0 + l15) * D + h * 128 + 16 * w + 4 * q4) = o; } \
        } while (0)
        for (int c = 0; c < 64; c += 2) { MS_STEP(PA, c); MS_STEP(PB, c + 1); }
#undef MS_STEP
    }
}

__device__ __forceinline__ int sw128(int r, int c) { return r * 136 + c; }
__device__ __forceinline__ int sw64(int r, int c) { return r * 72 + c; }
__device__ __forceinline__ void hgrn_prep(LAS unsigned char* lds, int tid, int bid, int G, bf16_t* QF, const bf16_t* VTT, bf16_t* OL, float* PFg) {
    tid = opaque_v(tid); bid = opaque_s(bid);
    const int lane = tid & 63, w = __builtin_amdgcn_readfirstlane(tid >> 6), l15 = lane & 15, q4 = lane >> 4;
    LAS bf16_t* QT = (LAS bf16_t*)(lds + 0);
    LAS bf16_t* KB = (LAS bf16_t*)(lds + 17408);
    LAS bf16_t* KH = (LAS bf16_t*)(lds + 34816);
    LAS bf16_t* QB = (LAS bf16_t*)(lds + 47872);
    LAS bf16_t* QH = (LAS bf16_t*)(lds + 65280);
    LAS bf16_t* KS = (LAS bf16_t*)(lds + 78336);
    LAS bf16_t* VT = (LAS bf16_t*)(lds + 96768);
    LAS bf16_t* AM = (LAS bf16_t*)(lds + 115200);
    LAS float* Fv = (LAS float*)(lds + 124416);
    const int d0 = 2 * (32 * (w & 1) + (lane & 31)), I = w >> 1, hf = lane >> 5, tb0 = 16 * I + 8 * hf;
    const int pr = tid >> 3, pp = tid & 7;
    unsigned pq2[8], pg2[8];
#define HP_PREFETCH(itx) do { const size_t qb_ = (size_t)(itx) * 16384 + (size_t)tb0 * 128 + d0; \
        _Pragma("unroll") for (int i = 0; i < 8; ++i) { pq2[i] = *(const unsigned*)(QF + qb_ + i * 128); pg2[i] = *(const unsigned*)(QF + qb_ + 8192 + i * 128); } \
        } while (0)
    if (bid < 4096) HP_PREFETCH(bid);
    for (int it = bid; it < 4096; it += G) {
        unsigned qtp[8], kbp[8];
        { float ca[8], cb[8], fa[8], fb[8]; float ea = 1.f, eb = 1.f;
#pragma unroll
          for (int i = 0; i < 8; ++i) { fa[i] = __expf(bf2f_lo(pg2[i])); fb[i] = __expf(bf2f_hi(pg2[i])); ea *= fa[i]; eb *= fb[i]; ca[i] = ea; cb[i] = eb; }
          const float ta = __shfl(ea, lane & 31), tb = __shfl(eb, lane & 31);
          const float pa = hf ? ta : 1.f, pb = hf ? tb : 1.f;
#pragma unroll
          for (int i = 0; i < 8; ++i) { const float e1a = ca[i] * pa, e1b = cb[i] * pb; const float ia = __builtin_amdgcn_rcpf(e1a), ib = __builtin_amdgcn_rcpf(e1b);
              qtp[i] = pk2(bf2f_lo(pq2[i]) * e1a, bf2f_hi(pq2[i]) * e1b); kbp[i] = pk2((1.f - fa[i]) * ia, (1.f - fb[i]) * ib);
              *(LAS unsigned*)(QT + sw128(tb0 + i, d0)) = qtp[i]; *(LAS unsigned*)(KB + sw128(tb0 + i, d0)) = kbp[i]; }
          if (hf) { Fv[I * 128 + d0] = ca[7] * pa; Fv[I * 128 + d0 + 1] = cb[7] * pb; } }
        __syncthreads();
        { const int itn_ = (it + G < 4096) ? it + G : it; HP_PREFETCH(itn_); }
        { const f32x2 F0 = *(const LAS f32x2*)(Fv + d0), F1 = *(const LAS f32x2*)(Fv + 128 + d0), F2 = *(const LAS f32x2*)(Fv + 256 + d0), F3 = *(const LAS f32x2*)(Fv + 384 + d0);
          const f32x2 one = (f32x2){1.f, 1.f};
          const f32x2 FI = (I == 0) ? F0 : (I == 1) ? F1 : (I == 2) ? F2 : F3;
          const f32x2 P = (I == 0) ? one : (I == 1) ? F0 : (I == 2) ? F0 * F1 : F0 * F1 * F2;
          const f32x2 suf = (I == 0) ? F1 * F2 * F3 : (I == 1) ? F2 * F3 : (I == 2) ? F3 : one;
          float ksa[8], ksb[8];
#pragma unroll
          for (int i = 0; i < 8; ++i) { const int t = tb0 + i; const float qa = bf2f_lo(qtp[i]), qb = bf2f_hi(qtp[i]); const float ka = bf2f_lo(kbp[i]) * FI.x, kb = bf2f_hi(kbp[i]) * FI.y;
              if (I < 3) *(LAS unsigned*)(KH + sw128(t, d0)) = pk2(ka, kb);
              *(LAS unsigned*)(QB + sw128(t, d0)) = pk2(qa * P.x, qb * P.y);
              ksa[i] = ka * suf.x; ksb[i] = kb * suf.y;
              if (I == 2) *(LAS unsigned*)(QH + sw128(8 * hf + i, d0)) = pk2(qa * F1.x, qb * F1.y);
              if (I == 3) { *(LAS unsigned*)(QH + sw128(16 + 8 * hf + i, d0)) = pk2(qa * F2.x, qb * F2.y);
                  *(LAS unsigned*)(QH + sw128(32 + 8 * hf + i, d0)) = pk2(qa * (F1.x * F2.x), qb * (F1.y * F2.y)); } }
          u32x4 oa, ob; oa.x = pk2(ksa[0], ksa[1]); oa.y = pk2(ksa[2], ksa[3]); oa.z = pk2(ksa[4], ksa[5]); oa.w = pk2(ksa[6], ksa[7]);
          ob.x = pk2(ksb[0], ksb[1]); ob.y = pk2(ksb[2], ksb[3]); ob.z = pk2(ksb[4], ksb[5]); ob.w = pk2(ksb[6], ksb[7]);
          *(LAS u32x4*)(KS + sw64(d0, tb0)) = oa; *(LAS u32x4*)(KS + sw64(d0 + 1, tb0)) = ob;
          if (I == 0 && hf == 0) { PFg[(size_t)it * 128 + d0] = (F0.x * F1.x) * (F2.x * F3.x); PFg[(size_t)it * 128 + d0 + 1] = (F0.y * F1.y) * (F2.y * F3.y); } }
        __syncthreads();
#pragma unroll
        for (int jj = 0; jj < 2; ++jj) { const int blk = 2 * w + jj, bi = blk >> 2, bj = blk & 3; const int t = 16 * bi + l15;
            if (bj > bi) { *(LAS u32x2*)(AM + sw64(t, 16 * bj + 4 * q4)) = (u32x2){0u, 0u}; }
            else { const LAS bf16_t* X; int xr; const LAS bf16_t* Yk = (bi == bj) ? KB : KH;
                if (bj + 1 >= bi) { X = QT; xr = 16 * bi; } else { X = QH; xr = (bi == 2) ? 0 : (bj == 1 ? 16 : 32); }
                f32x4 acc = (f32x4){0.f, 0.f, 0.f, 0.f};
#pragma unroll
                for (int kk = 0; kk < 4; ++kk) { const bf16x8 a = *(const LAS bf16x8*)(Yk + sw128(16 * bj + l15, 32 * kk + 8 * q4)), bq8 = *(const LAS bf16x8*)(X + sw128(xr + l15, 32 * kk + 8 * q4)); acc = MFMA16(a, bq8, acc); }
                float vv[4];
#pragma unroll
                for (int r = 0; r < 4; ++r) { const int s = 16 * bj + 4 * q4 + r; vv[r] = (s <= t) ? acc[r] : 0.f; }
                u32x2 o; o.x = pk2(vv[0], vv[1]); o.y = pk2(vv[2], vv[3]); *(LAS u32x2*)(AM + sw64(t, 16 * bj + 4 * q4)) = o; } }
        __syncthreads();
        *(u32x4*)(OL + (size_t)it * 4096 + tid * 8) = *(const LAS u32x4*)(AM + sw64(pr, 8 * pp));
#pragma unroll
        for (int j = 0; j < 2; ++j) { const int p = tid + 512 * j;
            *(u32x4*)(QF + (size_t)it * 16384 + p * 8) = *(const LAS u32x4*)(QB + sw128(p >> 4, 8 * (p & 15)));
            *(u32x4*)(QF + (size_t)it * 16384 + 8192 + p * 8) = *(const LAS u32x4*)(KS + sw64(p >> 3, 8 * (p & 7))); }
    }
#undef HP_PREFETCH
}

struct HsPf { u32x4 pqb, pks[2], pv0, pv1, pam; u32x2 pgt; f32x4 ppf; };
__device__ __forceinline__ void hs_load(HsPf& P, int it_, int qd, int tid, int lane, int w, int l15, int q4, const bf16_t* QF, const bf16_t* GT, const bf16_t* VTT, const bf16_t* OL, const float* PFg) {
    P.pqb = *(const u32x4*)(QF + (size_t)it_ * 16384 + (16 * qd) * 128 + (tid & 255) * 8);
#pragma unroll
    for (int j = 0; j < 2; ++j) P.pks[j] = *(const u32x4*)(QF + (size_t)it_ * 16384 + 8192 + (tid + 512 * j) * 8);
    P.pv0 = *(const u32x4*)(VTT + (size_t)it_ * 8192 + tid * 8); P.pv1 = *(const u32x4*)(VTT + (size_t)it_ * 8192 + 4096 + tid * 8);
    P.pam = *(const u32x4*)(OL + (size_t)it_ * 4096 + (16 * qd) * 64 + (tid & 127) * 8);
    P.pgt = *(const u32x2*)(GT + (size_t)it_ * 8192 + (16 * qd + l15) * 128 + 16 * w + 4 * q4);
    P.ppf = *(const f32x4*)(PFg + (size_t)it_ * 128 + 4 * (tid & 31));
}
__device__ __forceinline__ void hgrn_scan(LAS unsigned char* lds, int tid, int bid, int G, const bf16_t* QF, const bf16_t* GT, const bf16_t* VTT, const bf16_t* OL, const float* PFg, const float* normw, bf16_t* hh) {
    tid = opaque_v(tid); bid = opaque_s(bid);
    const int lane = tid & 63, w = __builtin_amdgcn_readfirstlane(tid >> 6), l15 = lane & 15, q4 = lane >> 4;
    LAS bf16_t* QB = (LAS bf16_t*)(lds + 0);
    LAS bf16_t* KS = (LAS bf16_t*)(lds + 17408);
    LAS bf16_t* VT = (LAS bf16_t*)(lds + 35840);
    LAS bf16_t* ST = (LAS bf16_t*)(lds + 54272);
    LAS float* PF = (LAS float*)(lds + 89088);
    LAS float* ssqp = (LAS float*)(lds + 89600);
    LAS float* nw = (LAS float*)(lds + 91648);
    LAS bf16_t* Aq = (LAS bf16_t*)(lds + 92160);
    const int pr = tid >> 3, pp = tid & 7;
    for (int v = bid; v < 256; v += G) {
        const int qd = (v >> 3) & 3, unit = (v & 7) + 8 * (v >> 5);
        const int b = unit >> 3, h = unit & 7; const size_t mb = (size_t)b * SEQ; const int item0 = unit * 64;
        __syncthreads();
        if (tid < 128) nw[tid] = normw[h * 128 + tid];
        for (int i = tid; i < 128 * 136 / 2; i += 512) ((LAS unsigned*)ST)[i] = 0u;
        f32x4 Sacc[8];
#pragma unroll
        for (int i = 0; i < 8; ++i) Sacc[i] = (f32x4){0.f, 0.f, 0.f, 0.f};
        HsPf PA, PB;
        hs_load(PA, item0, qd, tid, lane, w, l15, q4, QF, GT, VTT, OL, PFg); hs_load(PB, item0 + 1, qd, tid, lane, w, l15, q4, QF, GT, VTT, OL, PFg);
#define HS_STEP(P, cc) do { const size_t m0 = mb + (size_t)(cc) * 64 + 16 * qd; \
            if (tid < 256) *(LAS u32x4*)(QB + sw128(tid >> 4, 8 * (tid & 15))) = P.pqb; \
            _Pragma("unroll") for (int j = 0; j < 2; ++j) { const int p = tid + 512 * j; *(LAS u32x4*)(KS + sw64(p >> 3, 8 * (p & 7))) = P.pks[j]; } \
            *(LAS u32x4*)(VT + pr * 72 + 8 * pp) = P.pv0; *(LAS u32x4*)(VT + (64 + pr) * 72 + 8 * pp) = P.pv1; \
            if (tid < 32) *(LAS f32x4*)(PF + 4 * tid) = P.ppf; \
            if (tid < 128) *(LAS u32x4*)(Aq + pr * 72 + 8 * pp) = P.pam; \
            const u32x2 gg = P.pgt; \
            __syncthreads(); \
            { const int cn = ((cc) + 2 < 64) ? (cc) + 2 : 63; hs_load(P, item0 + cn, qd, tid, lane, w, l15, q4, QF, GT, VTT, OL, PFg); } \
            f32x4 ov = (f32x4){0.f, 0.f, 0.f, 0.f}; \
            bf16x8 vf[2]; \
            _Pragma("unroll") for (int kk = 0; kk < 2; ++kk) vf[kk] = *(const LAS bf16x8*)(VT + sw64(16 * w + l15, 32 * kk + 8 * q4)); \
            { bf16x8 sf[4], qf[4], af[2]; \
              _Pragma("unroll") for (int kk = 0; kk < 4; ++kk) { sf[kk] = *(const LAS bf16x8*)(ST + sw128(16 * w + l15, 32 * kk + 8 * q4)); qf[kk] = *(const LAS bf16x8*)(QB + sw128(l15, 32 * kk + 8 * q4)); } \
              _Pragma("unroll") for (int kk = 0; kk < 2; ++kk) af[kk] = *(const LAS bf16x8*)(Aq + l15 * 72 + 32 * kk + 8 * q4); \
              _Pragma("unroll") for (int kk = 0; kk < 2; ++kk) ov = MFMA16(vf[kk], af[kk], ov); \
              _Pragma("unroll") for (int kk = 0; kk < 4; ++kk) ov = MFMA16(sf[kk], qf[kk], ov); } \
            { \
              _Pragma("unroll") for (int dh = 0; dh < 2; ++dh) { bf16x8 kf[4][2]; \
                  _Pragma("unroll") for (int kk = 0; kk < 2; ++kk) _Pragma("unroll") for (int dq = 0; dq < 4; ++dq) kf[dq][kk] = *(const LAS bf16x8*)(KS + sw64(16 * (4 * dh + dq) + l15, 32 * kk + 8 * q4)); \
                  _Pragma("unroll") for (int dq = 0; dq < 4; ++dq) { const int di = 4 * dh + dq; const f32x4 pf = *(const LAS f32x4*)(PF + 16 * di + 4 * q4); Sacc[di] = Sacc[di] * pf; \
                      _Pragma("unroll") for (int kk = 0; kk < 2; ++kk) Sacc[di] = MFMA16(kf[dq][kk], vf[kk], Sacc[di]); } } } \
            { const float p = rows4_sum((ov[0] * ov[0] + ov[1] * ov[1]) + (ov[2] * ov[2] + ov[3] * ov[3])); if (lane < 16) ssqp[lane * 8 + w] = p; } \
            __syncthreads(); \
            _Pragma("unroll") for (int di = 0; di < 8; ++di) { u32x2 o; o.x = pk2_acc(Sacc[di][0], Sacc[di][1]); o.y = pk2_acc(Sacc[di][2], Sacc[di][3]); *(LAS u32x2*)(ST + sw128(16 * w + l15, 16 * di + 4 * q4)) = o; } \
            { const f32x4 nw4 = *(const LAS f32x4*)(nw + 16 * w + 4 * q4); \
              const f32x4 s0 = *(const LAS f32x4*)(ssqp + l15 * 8), s1 = *(const LAS f32x4*)(ssqp + l15 * 8 + 4); \
              const float ssum = ((s0[0] + s0[1]) + (s0[2] + s0[3])) + ((s1[0] + s1[1]) + (s1[2] + s1[3])); \
              const float rstd = rsqrtf(ssum * (1.f / 128.f) + EPS); \
              const float g0 = bf2f_lo(gg.x), g1 = bf2f_hi(gg.x), g2 = bf2f_lo(gg.y), g3 = bf2f_hi(gg.y); \
              u32x2 o; o.x = pk2(ov[0] * rstd * nw4[0] * g0, ov[1] * rstd * nw4[1] * g1); o.y = pk2(ov[2] * rstd * nw4[2] * g2, ov[3] * rstd * nw4[3] * g3); \
              *(u32x2*)(hh + (m0 + l15) * D + h * 128 + 16 * w + 4 * q4) = o; } \
        } while (0)
        for (int c = 0; c < 64; c += 2) { HS_STEP(PA, c); HS_STEP(PB, c + 1); }
#undef HS_STEP
    }
}

constexpr int N_PHASES = 34;
#ifndef MK_KIND_MASK
#define MK_KIND_MASK 0x3FFFF
#endif
#define KIND(k) ((MK_KIND_MASK >> (k)) & 1)
#ifndef MK_TWICE_MASK
#define MK_TWICE_MASK 0
#endif
#define TWICE(k, body) do { body; if ((MK_TWICE_MASK >> (k)) & 1) { xcd_barrier(bar); body; } } while (0)
#ifndef MK_CUT
#define MK_CUT 32
#endif
#define tid (wave_s * 64 + lane_id())
#define IN(k) (lo <= (k) && (k) < hi)
#define SEAM(k) do { if (IN(k) && IN((k) + 1)) { if (MK_N_LAUNCHES == 1) xcd_barrier(bar); else if (tid == 0) __hip_atomic_store(ctl + CW_TMO, 0xBAD0u, __ATOMIC_RELAXED, __HIP_MEMORY_SCOPE_AGENT); } } while (0)
#define ws (kws())
#define ctl ((unsigned*)(ws + WS_CTL))
#define mod ((float*)(ws + WS_MOD))
#define xo ((bf16_t*)kout())
#define R1 ((bf16_t*)(ws + WS_R1))
#define HN ((bf16_t*)(ws + WS_R2))
#define YB ((bf16_t*)(ws + WS_R2))
#define LI ((float*)(ws + WS_LI))
#define LF ((float*)(ws + WS_LF))
#define LTOK ((int*)(ws + WS_LTOK))
#define LW ((float*)(ws + WS_LW))


template <int LP>
__device__ __forceinline__ void layer_pair(LAS unsigned char* lds, const int wave_s, const int bid, const int G, const int lo, const int hi, const XcdBarrier& bar) {
        constexpr int lp = LP;
        const int pb = 1 + 16 * lp;
        unsigned char* wb = ws + WS_WGT + (size_t)lp * LP_BYTES;
        unsigned* gcnt = ctl + CW_CNT + 64 * lp;
        { const int L = 2 * lp; const float* modL = mod + (size_t)L * 8 * 6144;
          const bf16_t* hnA = (lp == 0) ? HN : (const bf16_t*)(ws + WS_R1);
          bf16_t* QKR = (bf16_t*)(ws + WS_R1 + (lp == 0 ? 0 : 64) * MiB);
          bf16_t* OGT = (bf16_t*)(ws + WS_R1 + (lp == 0 ? 64 : 128) * MiB);
          bf16_t* VTm = (bf16_t*)(ws + WS_R1 + (lp == 0 ? 128 : 192) * MiB);
          bf16_t* QKT = (bf16_t*)(ws + WS_R1 + (lp == 0 ? 192 : 0) * MiB);
          bf16_t* UU = (bf16_t*)(ws + WS_R2U);
          if (KIND(1) && IN(pb + 0)) {
              if (lp == 0) TWICE(1, (norm_phase<1, false, true>(lds, tid, bid, G, karg(I_X), xo, YB, karg(I_N1W) + L * 1024, modL + 0, modL + 1024, HN, (const float*)(wb + W_MGATE), karg(I_MIB) + lp * 8, karg(I_MFB) + lp * 8, LI, LF, nullptr, nullptr, nullptr)));
              else norm_phase<1, true>(lds, tid, bid, G, xo, xo, YB, karg(I_N1W) + L * 1024, modL + 0, modL + 1024, (bf16_t*)(ws + WS_R1), (const float*)(wb + W_MGATE), karg(I_MIB) + lp * 8, karg(I_MFB) + lp * 8, LI, LF, nullptr, nullptr, nullptr);
          }
          SEAM(pb + 0);
          if (KIND(2) && IN(pb + 1)) {
              { pg8::Gemm g{hnA, (const bf16_t*)(wb + W_MIN), T, 2048, D, 0}; pg8::StaticOrder S; S.init(T, 2048, G, bid);
                pg8::EpiTile<0> E{QKR, OGT, karg(I_MNW) + lp * 1024};
                TWICE(2, (pg8::gemm_phase<pg8::EpiTile<0>, pg8::StaticOrder, true, false>(lds, g, S, E, wave_s))); }
              { pg8::Gemm g{(const bf16_t*)(wb + W_MIN) + (size_t)2048 * 1024, hnA, 1024, T, D, 0}; pg8::StaticOrder S; S.init(1024, T, G, bid);
                pg8::EpiVT E{VTm};
                TWICE(2, (pg8::gemm_phase<pg8::EpiVT, pg8::StaticOrder, true, false>(lds, g, S, E, wave_s))); }
          }
          SEAM(pb + 1);
          if (KIND(16) && IN(pb + 2)) TWICE(16, mlstm_prep(lds, tid, bid, G, QKR, OGT, VTm, LI, LF, (f32x4*)(ws + WS_SCT), (f32x4*)(ws + WS_SCI), karg(I_MCW) + (size_t)lp * 4 * 1024, karg(I_MCB) + lp * 1024, karg(I_MNW) + lp * 1024, QKT, UU));
          SEAM(pb + 2);
          if (KIND(3) && IN(pb + 3)) { TWICE(3, mlstm_scan(lds, tid, bid, G, OGT, VTm, (const f32x4*)(ws + WS_SCT), (const f32x4*)(ws + WS_SCI), QKT, UU, HN));
 }
          SEAM(pb + 3);
          if (KIND(4) && IN(pb + 4)) {
              pg8::Gemm g{HN, (const bf16_t*)(wb + W_MOUT), T, D, D, 0}; pg8::StaticOrder S; S.init(T, D, G, bid);
              if (lp == 0) { pg8::EpiResid<true> E{karg(I_X), xo, modL + 2048}; pg8::gemm_phase<pg8::EpiResid<true>, pg8::StaticOrder, true, false>(lds, g, S, E, wave_s); }
              else { pg8::EpiResid<false> E{xo, xo, modL + 2048}; pg8::gemm_phase<pg8::EpiResid<false>, pg8::StaticOrder, true, false>(lds, g, S, E, wave_s); }
          }
          SEAM(pb + 4);
          if (KIND(5) && IN(pb + 5)) TWICE(5, (norm_phase<0, false>(lds, tid, bid, G, xo, xo, YB, karg(I_N2W) + L * 1024, modL + 3072, modL + 4096, HN, nullptr, nullptr, nullptr, nullptr, nullptr, nullptr, nullptr, nullptr)));
          SEAM(pb + 5);
          if (KIND(6) && IN(pb + 6)) {
              pg8::Gemm g{HN, (const bf16_t*)(wb + W_FGU), T, 2 * DFF, D, 0}; pg8::StaticOrder S; S.init(T, 2 * DFF, G, bid);
              pg8::EpiSwiGLU E{R1, DFF};
              TWICE(6, (pg8::gemm_phase<pg8::EpiSwiGLU, pg8::StaticOrder, true, false>(lds, g, S, E, wave_s)));
          }
          SEAM(pb + 6);
          if (KIND(7) && IN(pb + 7)) {
              pg8::Gemm g{R1, (const bf16_t*)(wb + W_FD), T, D, DFF, 0}; pg8::StaticOrder S; S.init(T, D, G, bid);
              pg8::EpiResid<false> E{xo, xo, modL + 5120};
              pg8::gemm_phase<pg8::EpiResid<false>, pg8::StaticOrder, true, false>(lds, g, S, E, wave_s);
          }
          SEAM(pb + 7);
        }
        { const int L = 2 * lp + 1; const float* modL = mod + (size_t)L * 8 * 6144;
          bf16_t* QF = R1;
          bf16_t* GT = (bf16_t*)(ws + WS_R1 + 128 * MiB);
          bf16_t* VTh = (bf16_t*)(ws + WS_R1 + 192 * MiB);
          bf16_t* OL = (bf16_t*)(ws + WS_R2U);
          float* PFg = (float*)(ws + WS_RS);
          if (KIND(8) && IN(pb + 8)) norm_phase<0, false>(lds, tid, bid, G, xo, xo, YB, karg(I_N1W) + L * 1024, modL + 0, modL + 1024, HN, nullptr, nullptr, nullptr, nullptr, nullptr, nullptr, nullptr, nullptr);
          SEAM(pb + 8);
          if (KIND(9) && IN(pb + 9)) {
              { pg8::Gemm g{HN, (const bf16_t*)(wb + W_HIN), T, 3072, D, 0}; pg8::StaticOrder S; S.init(T, 3072, G, bid);
                pg8::EpiTile<1> E{QF, GT, (lp == 0) ? nullptr : (const float*)(ws + WS_LB)};
                TWICE(9, (pg8::gemm_phase<pg8::EpiTile<1>, pg8::StaticOrder, true, false>(lds, g, S, E, wave_s))); }
              { pg8::Gemm g{(const bf16_t*)(wb + W_HIN) + (size_t)3072 * 1024, HN, 1024, T, D, 0}; pg8::StaticOrder S; S.init(1024, T, G, bid);
                pg8::EpiVT E{VTh};
                TWICE(9, (pg8::gemm_phase<pg8::EpiVT, pg8::StaticOrder, true, false>(lds, g, S, E, wave_s))); }
          }
          SEAM(pb + 9);
          if (KIND(17) && IN(pb + 10)) TWICE(17, hgrn_prep(lds, tid, bid, G, QF, VTh, OL, PFg));
          SEAM(pb + 10);
          if (KIND(10) && IN(pb + 11)) TWICE(10, hgrn_scan(lds, tid, bid, G, QF, GT, VTh, OL, PFg, karg(I_HNW) + lp * 1024, HN));
          SEAM(pb + 11);
          if (KIND(11) && IN(pb + 12)) {
              pg8::Gemm g{HN, (const bf16_t*)(wb + W_HOUT), T, D, D, 0}; pg8::StaticOrder S; S.init(T, D, G, bid);
              pg8::EpiResid<false> E{xo, xo, modL + 2048};
              pg8::gemm_phase<pg8::EpiResid<false>, pg8::StaticOrder, true, false>(lds, g, S, E, wave_s);
          }
          SEAM(pb + 12);
          if (KIND(12) && IN(pb + 13)) norm_phase<2, false>(lds, tid, bid, G, xo, xo, YB, karg(I_N2W) + L * 1024, modL + 3072, modL + 4096, HN, (const float*)(wb + W_ROUT), nullptr, nullptr, nullptr, nullptr, gcnt, LTOK, LW);
          SEAM(pb + 13);
          if (KIND(13) && IN(pb + 14)) {
              pg8::Gemm g{HN, (const bf16_t*)(wb + W_EGU), T, 2 * DFE, D, (size_t)2 * DFE * D}; pg8::MoeOrder S; S.init(gcnt, LTOK, (2 * DFE) / 256, G, bid, (LAS int*)(lds + MISC_OFF + 64), wave_s);
              pg8::EpiSwiGLU E{R1, DFE};
              TWICE(13, (pg8::gemm_phase<pg8::EpiSwiGLU, pg8::MoeOrder, true, true>(lds, g, S, E, wave_s)));
              if (lp == 0) tail_convert(lds, tid, bid, G, S.nwg, CV_PER_LP, CV_PER_LP + CV_TAIL1);
          }
          SEAM(pb + 14);
          if (KIND(14) && IN(pb + 15)) {
              pg8::Gemm g{R1, (const bf16_t*)(wb + W_ED), T, D, DFE, (size_t)D * DFE}; pg8::MoeOrder S; S.init(gcnt, LTOK, D / 256, G, bid, (LAS int*)(lds + MISC_OFF + 64), wave_s);
              pg8::EpiMoeDown E{YB, LTOK, LW, gcnt, modL + 5120};
              TWICE(14, (pg8::gemm_phase<pg8::EpiMoeDown, pg8::MoeOrder, true, false>(lds, g, S, E, wave_s)));
              if (lp == 0) tail_convert(lds, tid, bid, G, S.nwg, CV_PER_LP + CV_TAIL1, 2 * CV_PER_LP);
          }
          SEAM(pb + 15);
        }
}

__global__ void __launch_bounds__(512, 2) mk_fwd(Args args) {
    extern __shared__ __attribute__((aligned(16))) unsigned char lds_raw[];
    LAS unsigned char* lds = (LAS unsigned char*)lds_raw;
    const int wave_s = __builtin_amdgcn_readfirstlane((int)threadIdx.x >> 6);
    const int bid = blockIdx.x, G = gridDim.x;
    volatile LAS unsigned* MISC = (volatile LAS unsigned*)(lds + MISC_OFF);
    if (tid < 64) MISC[tid] = 0u;
    __syncthreads();
    XcdBarrier bar; bar.bar = (unsigned*)(kws() + WS_CTL) + CW_BAR; bar.x = 0; bar.st = nullptr; bar.wv = wave_s;
    if (MK_N_LAUNCHES == 1) bar = xcd_barrier_post((unsigned*)(kws() + WS_CTL) + CW_BAR, MISC, wave_s);
    const int lo = __builtin_amdgcn_readfirstlane(args.ph_lo), hi = __builtin_amdgcn_readfirstlane(args.ph_hi);
    if (KIND(0) && IN(0)) { TWICE(0, p0_phase(lds, tid, bid, G)); }
    SEAM(0);
    layer_pair<0>(lds, wave_s, bid, G, lo, hi, bar);
    layer_pair<1>(lds, wave_s, bid, G, lo, hi, bar);
    if (KIND(15) && IN(33)) { if (MK_CUT >= 32 || MK_CUT == 16) final_phase<true>(tid, bid, G, kout(), YB, karg(I_FNW)); else final_phase<false>(tid, bid, G, kout(), YB, karg(I_FNW)); }
#undef IN
#undef SEAM
#undef tid
#undef ws
#undef ctl
#undef mod
#undef xo
#undef R1
#undef HN
#undef YB
#undef LI
#undef LF
#undef LTOK
#undef LW
}

extern "C" void kernel_launch(void* const* d_in, const int* in_sizes, int n_in, void* d_out, int out_size, void* d_ws, size_t ws_size, hipStream_t stream) {
    static int grid = 0;
    if (grid == 0) {
        if (n_in != 25 || in_sizes[0] != T * D || out_size != T * D || ws_size < WS_END2) {
            fprintf(stderr, "kernel_launch: unexpected shapes (n_in %d, in0 %d, out %d, ws %zu < %zu)\n", n_in, n_in > 0 ? in_sizes[0] : -1, out_size, ws_size, (size_t)WS_END2); grid = -1; }
        else {
            int dev = 0, cus = 0;
            if (hipGetDevice(&dev) != hipSuccess || hipDeviceGetAttribute(&cus, hipDeviceAttributeMultiprocessorCount, dev) != hipSuccess) { grid = -1; }
            else if (hipFuncSetAttribute((const void*)mk_fwd, hipFuncAttributeMaxDynamicSharedMemorySize, LDS_BYTES) != hipSuccess) { fprintf(stderr, "kernel_launch: hipFuncSetAttribute failed\n"); grid = -1; }
            else { int per_cu = 0; (void)hipOccupancyMaxActiveBlocksPerMultiprocessor(&per_cu, (const void*)mk_fwd, 512, LDS_BYTES); (void)hipGetLastError();
                if (per_cu < 1) fprintf(stderr, "kernel_launch: occupancy query reports %d blocks per CU\n", per_cu);
                grid = cus; }
        }
    }
    if (grid < 0) { (void)hipMemsetAsync(d_out, 0xFF, (size_t)out_size * 4, stream); return; }
    (void)hipMemsetAsync((char*)d_ws + WS_CTL, 0, CTL_ZERO_BYTES, stream);
    Args a{};
    for (int i = 0; i < 25; ++i) a.in[i] = (const float*)d_in[i];
    a.out = (float*)d_out; a.ws = (unsigned char*)d_ws;
    if (MK_N_LAUNCHES == 1) { a.ph_lo = 0; a.ph_hi = N_PHASES; hipLaunchKernelGGL(mk_fwd, dim3(grid), dim3(512), LDS_BYTES, stream, a); }
    else { for (int p = 0; p < N_PHASES; ++p) { if (p > MK_CUT && p != N_PHASES - 1) continue; a.ph_lo = p; a.ph_hi = p + 1; hipLaunchKernelGGL(mk_fwd, dim3(grid), dim3(512), LDS_BYTES, stream, a); } }
}
```

```cpp
#include <hip/hip_runtime.h>
#include <cstdio>
#include <cstdint>

#ifndef MK_N_LAUNCHES
#define MK_N_LAUNCHES 1
#endif

#define LAS __attribute__((address_space(3)))
#define GAS __attribute__((address_space(1)))
typedef unsigned short bf16_t;
typedef short bf16x8 __attribute__((ext_vector_type(8)));
typedef float f32x4 __attribute__((ext_vector_type(4)));
typedef float f32x2 __attribute__((ext_vector_type(2)));
typedef unsigned u32x4 __attribute__((ext_vector_type(4)));
typedef unsigned u32x2 __attribute__((ext_vector_type(2)));

constexpr int BATCH = 8, SEQ = 4096, D = 1024, T = BATCH * SEQ;
constexpr int MPROJ = 3088, MPROJ_G = 3072;
constexpr int HPROJ = 4096;
constexpr int DFF = 2816, NE = 8, DFE = 1408;
constexpr float EPS = 1e-6f;
constexpr int XP = 2048;

constexpr size_t MiB = 1u << 20;
constexpr size_t WS_CTL = 0, CTL_ZERO_BYTES = 65536;
constexpr int CW_TMO = 0, CW_BAR = 4096, CW_CNT = 8192;
constexpr size_t WS_MOD = 1 * MiB;
constexpr size_t WS_LB = WS_MOD + (size_t)4 * 8 * 6144 * 4;
constexpr size_t WS_LI = 2 * MiB, WS_LF = 3 * MiB;
constexpr size_t WS_LTOK = 4 * MiB, WS_LW = 5 * MiB;
constexpr size_t WS_RS = 6 * MiB, WS_KN = 7 * MiB;
constexpr size_t WS_WGT = 8 * MiB;
constexpr size_t W_MIN = 0;
constexpr size_t W_MGATE = W_MIN + (size_t)3072 * 1024 * 2;
constexpr size_t W_MOUT = W_MGATE + 16 * 1024 * 4;
constexpr size_t W_FGU = W_MOUT + (size_t)1024 * 1024 * 2;
constexpr size_t W_FD = W_FGU + (size_t)5632 * 1024 * 2;
constexpr size_t W_HIN = W_FD + (size_t)1024 * 2816 * 2;
constexpr size_t W_HOUT = W_HIN + (size_t)4096 * 1024 * 2;
constexpr size_t W_ROUT = W_HOUT + (size_t)1024 * 1024 * 2;
constexpr size_t W_EGU = W_ROUT + 8 * 1024 * 4;
constexpr size_t W_ED = W_EGU + (size_t)8 * 2816 * 1024 * 2;
constexpr size_t LP_BYTES = W_ED + (size_t)8 * 1024 * 1408 * 2;
constexpr size_t WS_R1 = ((WS_WGT + 2 * LP_BYTES + MiB - 1) / MiB) * MiB;
constexpr size_t WS_R2 = WS_R1 + 256 * MiB;
constexpr size_t WS_END = WS_R2 + 128 * MiB;
constexpr size_t WS_SCT = WS_END, WS_SCI = WS_END + 4 * MiB, WS_END2 = WS_END + 8 * MiB;
constexpr size_t WS_R2U = WS_R2 + 64 * MiB;
static_assert(LP_BYTES % 16 == 0 && W_MGATE % 16 == 0 && W_ROUT % 16 == 0, "alignment");

constexpr int LDS_BYTES = 163840;
constexpr int MISC_OFF = LDS_BYTES - 256;

__device__ __forceinline__ float bf2f_lo(unsigned w) { return __builtin_bit_cast(float, w << 16); }
__device__ __forceinline__ float bf2f_hi(unsigned w) { return __builtin_bit_cast(float, w & 0xffff0000u); }
__device__ __forceinline__ float bf2f(unsigned short u) { return __builtin_bit_cast(float, (unsigned)u << 16); }
__device__ __forceinline__ unsigned f2bf(float f) { unsigned u = __builtin_bit_cast(unsigned, f); return (u + 0x7fffu + ((u >> 16) & 1u)) >> 16; }
__device__ __forceinline__ unsigned pk2(float lo, float hi) { unsigned r; asm volatile("v_cvt_pk_bf16_f32 %0, %1, %2" : "=v"(r) : "v"(lo), "v"(hi)); return r; }
typedef __bf16 bf16x2_t __attribute__((ext_vector_type(2)));
__device__ __forceinline__ unsigned pk2_acc(float lo, float hi) { const f32x2 v = {lo, hi}; const bf16x2_t b = __builtin_convertvector(v, bf16x2_t); return __builtin_bit_cast(unsigned, b); }
__device__ __forceinline__ float wave_sum(float v) {
#pragma unroll
    for (int o = 1; o < 64; o <<= 1) v += __shfl_xor(v, o);
    return v;
}
__device__ __forceinline__ float sigmoidf_(float x) { return __builtin_amdgcn_rcpf(1.f + __expf(-x)); }
__device__ __forceinline__ float siluf_(float x) { return x * __builtin_amdgcn_rcpf(1.f + __expf(-x)); }
__device__ __forceinline__ int lane_id() { return (int)__builtin_amdgcn_mbcnt_hi(~0u, __builtin_amdgcn_mbcnt_lo(~0u, 0u)); }
__device__ __forceinline__ int opaque_v(int x) { asm volatile("" : "+v"(x)); return x; }
__device__ __forceinline__ int opaque_s(int x) { asm volatile("" : "+s"(x)); return x; }
__device__ __forceinline__ float rows4_sum(float p) { p += __shfl_xor(p, 16); p += __shfl_xor(p, 32); return p; }
#define MFMA16(a, b, c) __builtin_amdgcn_mfma_f32_16x16x32_bf16((a), (b), (c), 0, 0, 0)
#define LDS_ADDF(p, v) __hip_atomic_fetch_add((p), (v), __ATOMIC_RELAXED, __HIP_MEMORY_SCOPE_WORKGROUP)

namespace pg8 {
#define PG8_LAS __attribute__((address_space(3)))
constexpr int BM = 256, BK = 64, HALF = 128, HTB = HALF * BK * 2, STAGE_BYTES = 8 * HTB, NXCD = 8, WGM = 8;
__host__ __device__ __forceinline__ int lds_byte(int r, int c) { const int st = (r >> 4) * 2 + (c >> 5), rr = r & 15, cc = c & 31, ob = rr * 64 + cc * 2; return st * 1024 + (ob ^ (((ob >> 9) & 1) << 5)); }
__host__ __device__ __forceinline__ void stage_rc(int b, int& R, int& C) { const int st = b / 1024, sb = b % 1024, swz = sb ^ (((sb >> 9) & 1) << 5); R = (st >> 1) * 16 + swz / 64; C = (st & 1) * 32 + (swz % 64) / 2; }
__host__ __device__ __forceinline__ int perm32(int rho) { const int n = rho >> 4, i = rho & 15; return 8 * (i >> 2) + 4 * n + (i & 3); }

struct Unit { int pm, pn, e, lrow; };
struct Gemm { const bf16_t* A; const bf16_t* Bt; int M, N, K; size_t bexp; };

struct StaticOrder {
    int nM, nN, nwg, G, c;
    __device__ __forceinline__ void init(int M, int N, int G_, int c_) { nM = M / BM; nN = N / BM; nwg = nM * nN; G = G_; c = c_; }
    __device__ __forceinline__ bool next(int i, Unit& u) const {
        const long L = (long)i * G + c; if (L >= nwg) return false;
        int wgid = (int)L; { const int q = nwg / NXCD, r = nwg % NXCD, xcd = wgid % NXCD, off = wgid / NXCD; wgid = (xcd < r ? xcd * (q + 1) : r * (q + 1) + (xcd - r) * q) + off; }
        const int nig = WGM * nN, gid = wgid / nig, fm = gid * WGM, gsz = (nM - fm) < WGM ? (nM - fm) : WGM;
        u.pm = fm + ((wgid % nig) % gsz); u.pn = (wgid % nig) / gsz; u.e = 0; u.lrow = 0; return true;
    }
    __device__ __forceinline__ int row_index(const Unit&, int) const { return 0; }
};
struct MoeOrder {
    int nM, nN, nwg, G, c; const PG8_LAS int* tab; const int* lst; const unsigned* cnt;
    __device__ __forceinline__ void init(const unsigned* cnt_, const int* lst_, int nN_, int G_, int c_, PG8_LAS int* tab_, int wid) {
        if (wid == 0 && lane_id() == 0) { int acc = 0; tab_[0] = 0;
            for (int e = 0; e < 8; ++e) { int v = (int)cnt_[e]; v = v < 0 ? 0 : (v > T ? T : v); tab_[16 + e] = v; acc += (v + 255) / 256; tab_[e + 1] = acc; } }
        __syncthreads();
        tab = tab_; nM = tab_[8]; nN = nN_; nwg = nM * nN; G = G_; c = c_; lst = lst_; cnt = cnt_;
    }
    __device__ __forceinline__ bool next(int i, Unit& u) const {
        const long L = (long)i * G + c; if (L >= nwg) return false;
        int wgid = (int)L; { const int q = nwg / NXCD, r = nwg % NXCD, xcd = wgid % NXCD, off = wgid / NXCD; wgid = (xcd < r ? xcd * (q + 1) : r * (q + 1) + (xcd - r) * q) + off; }
        const int nig = WGM * nN, gid = wgid / nig, fm = gid * WGM, gsz = (nM - fm) < WGM ? (nM - fm) : WGM;
        u.pm = fm + ((wgid % nig) % gsz); u.pn = (wgid % nig) / gsz;
        int e = 0;
        for (int k = 1; k < 8; ++k) { if (u.pm >= tab[k]) e = k; }
        u.e = e; u.lrow = (u.pm - tab[e]) * 256; return true;
    }
    __device__ __forceinline__ int row_index(const Unit& u, int r) const {
        const int pos = u.lrow + r; const int n = tab[16 + u.e];
        const int v = lst[(size_t)u.e * T + (pos < n ? pos : 0)] >> 1;
        return pos < n ? v : 0;
    }
};

template <int MODE> struct EpiBf16 {
    static constexpr bool PERM = true, AFTER_DRAIN = false;
    bf16_t* O; int ldc; const float* lb;
    __device__ __forceinline__ void operator()(const f32x4 (&acc)[2][2][4][2], const Unit& u, int wr, int wc, int fr, int fq) const {
        const int row0 = u.pm * BM + wr * 64 + fr; const int col0 = u.pn * BM + wc * 32 + 8 * fq;
        const int kind = (MODE == 1) ? (u.pn >> 2) : 2;
        f32x4 lbv[2][2];
        if (MODE == 1 && kind == 1) {
#pragma unroll
            for (int bj = 0; bj < 2; ++bj)
#pragma unroll
                for (int n = 0; n < 2; ++n) lbv[bj][n] = lb ? *(const f32x4*)(lb + (col0 - 1024) + bj * HALF + 4 * n) : (f32x4){0.f, 0.f, 0.f, 0.f};
        }
#pragma unroll
        for (int ai = 0; ai < 2; ++ai)
#pragma unroll
            for (int m = 0; m < 4; ++m) { bf16_t* rowp = O + (size_t)(row0 + ai * HALF + m * 16) * ldc + col0;
#pragma unroll
                for (int bj = 0; bj < 2; ++bj) { f32x4 v0 = acc[ai][bj][m][0], v1 = acc[ai][bj][m][1];
                    if (MODE == 1) {
                        if (kind == 0 || kind == 2) {
#pragma unroll
                            for (int j = 0; j < 4; ++j) { v0[j] = siluf_(v0[j]); v1[j] = siluf_(v1[j]); }
                        } else if (kind == 1) {
#pragma unroll
                            for (int j = 0; j < 4; ++j) { const float l0 = lbv[bj][0][j], l1 = lbv[bj][1][j];
                                v0[j] = logf(fmaxf(l0 + (1.f - l0) * sigmoidf_(v0[j]), 1e-30f)); v1[j] = logf(fmaxf(l1 + (1.f - l1) * sigmoidf_(v1[j]), 1e-30f)); }
                        }
                    }
                    u32x4 w; w.x = pk2(v0[0], v0[1]); w.y = pk2(v0[2], v0[3]); w.z = pk2(v1[0], v1[1]); w.w = pk2(v1[2], v1[3]);
                    *(u32x4*)(rowp + bj * HALF) = w; } }
    }
};
template <int KIND> struct EpiTile {
    static constexpr bool PERM = true, AFTER_DRAIN = false;
    bf16_t* QK; bf16_t* OG; const float* lb;
    __device__ __forceinline__ void operator()(const f32x4 (&acc)[2][2][4][2], const Unit& u, int wr, int wc, int fr, int fq) const {
        constexpr int HD = (KIND == 0) ? 64 : 128, NQK = 2 * 8 * HD;
        const int row0 = u.pm * BM + wr * 64 + fr;
#pragma unroll
        for (int bj = 0; bj < 2; ++bj) { const int c = u.pn * BM + bj * HALF + wc * 32 + 8 * fq;
            const bool isqk = c < NQK; const int which = isqk ? (c / (8 * HD)) : 0; const int cc = isqk ? (c % (8 * HD)) : (c - NQK);
            const int h = isqk ? (cc / HD) : (cc >> 7), d = isqk ? (cc % HD) : (cc & 127);
            f32x4 l0 = (f32x4){0.f, 0.f, 0.f, 0.f}, l1 = l0;
            { const float* lbp = lb ? lb : (const float*)QK;
              const f32x4 t0 = *(const f32x4*)(lbp + h * 128 + d), t1 = *(const f32x4*)(lbp + h * 128 + d + 4);
              if ((KIND == 1 && isqk && which == 1 && lb) || (KIND == 0 && !isqk)) { l0 = t0; l1 = t1; } }
#pragma unroll
            for (int ai = 0; ai < 2; ++ai)
#pragma unroll
                for (int m = 0; m < 4; ++m) { const int r = row0 + ai * HALF + m * 16; const int item = (((r >> 12) * 8 + h) << 6) + ((r >> 6) & 63), t = r & 63;
                    f32x4 v0 = acc[ai][bj][m][0], v1 = acc[ai][bj][m][1];
                    if (KIND == 0 && !isqk) {
#pragma unroll
                        for (int j = 0; j < 4; ++j) { v0[j] = sigmoidf_(v0[j]) * l0[j]; v1[j] = sigmoidf_(v1[j]) * l1[j]; }
                    }
                    if (KIND == 1) {
                        if (isqk && which == 1) {
#pragma unroll
                            for (int j = 0; j < 4; ++j) { v0[j] = __logf(fmaxf(l0[j] + (1.f - l0[j]) * sigmoidf_(v0[j]), 1e-30f)); v1[j] = __logf(fmaxf(l1[j] + (1.f - l1[j]) * sigmoidf_(v1[j]), 1e-30f)); }
                        } else {
#pragma unroll
                            for (int j = 0; j < 4; ++j) { v0[j] = siluf_(v0[j]); v1[j] = siluf_(v1[j]); }
                        }
                    }
                    u32x4 w; w.x = pk2(v0[0], v0[1]); w.y = pk2(v0[2], v0[3]); w.z = pk2(v1[0], v1[1]); w.w = pk2(v1[2], v1[3]);
                    bf16_t* p = isqk ? (QK + ((size_t)(item * 2 + which) * 64 + t) * HD + d) : (OG + ((size_t)item * 64 + t) * 128 + d);
                    *(u32x4*)p = w; } }
    }
};
struct EpiVT {
    static constexpr bool PERM = true, AFTER_DRAIN = false;
    bf16_t* VT;
    __device__ __forceinline__ void operator()(const f32x4 (&acc)[2][2][4][2], const Unit& u, int wr, int wc, int fr, int fq) const {
        const int row0 = u.pm * BM + wr * 64 + fr;
#pragma unroll
        for (int bj = 0; bj < 2; ++bj) { const int tok = u.pn * BM + bj * HALF + wc * 32 + 8 * fq; const int b = tok >> 12, ch = (tok >> 6) & 63, s = tok & 63;
#pragma unroll
            for (int ai = 0; ai < 2; ++ai)
#pragma unroll
                for (int m = 0; m < 4; ++m) { const int c = row0 + ai * HALF + m * 16; const int h = c >> 7, dv = c & 127; const int item = ((b * 8 + h) << 6) + ch;
                    const f32x4 v0 = acc[ai][bj][m][0], v1 = acc[ai][bj][m][1];
                    u32x4 w; w.x = pk2(v0[0], v0[1]); w.y = pk2(v0[2], v0[3]); w.z = pk2(v1[0], v1[1]); w.w = pk2(v1[2], v1[3]);
                    *(u32x4*)(VT + ((size_t)item * 128 + dv) * 64 + s) = w; } }
    }
};
template <bool XIN_F32> struct EpiResid {
    static constexpr bool PERM = true, AFTER_DRAIN = false;
    const void* xin; bf16_t* xout; const float* gate;
    __device__ __forceinline__ void operator()(const f32x4 (&acc)[2][2][4][2], const Unit& u, int wr, int wc, int fr, int fq) const {
        const int row0 = u.pm * BM + wr * 64 + fr, col0 = u.pn * BM + wc * 32 + 8 * fq; const int b = u.pm >> 4;
        f32x4 gv[2][2];
#pragma unroll
        for (int bj = 0; bj < 2; ++bj)
#pragma unroll
            for (int n = 0; n < 2; ++n) gv[bj][n] = *(const f32x4*)(gate + (size_t)b * 6144 + col0 + bj * HALF + n * 4);
#pragma unroll
        for (int ai = 0; ai < 2; ++ai) {
            f32x4 x0[4][2], x1[4][2];
#pragma unroll
            for (int m = 0; m < 4; ++m) { const size_t row = (size_t)(row0 + ai * HALF + m * 16);
#pragma unroll
                for (int bj = 0; bj < 2; ++bj) {
                    if (XIN_F32) { const float* p = (const float*)xin + row * D + col0 + bj * HALF; x0[m][bj] = *(const f32x4*)p; x1[m][bj] = *(const f32x4*)(p + 4); }
                    else { const u32x4 v = *(const u32x4*)((const bf16_t*)xin + row * XP + col0 + bj * HALF);
                        x0[m][bj] = (f32x4){bf2f_lo(v.x), bf2f_hi(v.x), bf2f_lo(v.y), bf2f_hi(v.y)}; x1[m][bj] = (f32x4){bf2f_lo(v.z), bf2f_hi(v.z), bf2f_lo(v.w), bf2f_hi(v.w)}; } } }
            asm volatile("" ::: "memory");
#pragma unroll
            for (int m = 0; m < 4; ++m) { const size_t row = (size_t)(row0 + ai * HALF + m * 16);
#pragma unroll
                for (int bj = 0; bj < 2; ++bj) {
                    const f32x4 y0 = x0[m][bj] + gv[bj][0] * acc[ai][bj][m][0], y1 = x1[m][bj] + gv[bj][1] * acc[ai][bj][m][1];
                    u32x4 o; o.x = pk2(y0[0], y0[1]); o.y = pk2(y0[2], y0[3]); o.z = pk2(y1[0], y1[1]); o.w = pk2(y1[2], y1[3]);
                    *(u32x4*)(xout + row * XP + col0 + bj * HALF) = o; } }
            asm volatile("" ::: "memory");
        }
    }
};
struct EpiSwiGLU {
    static constexpr bool PERM = true, AFTER_DRAIN = false;
    bf16_t* O; int ldc;
    __device__ __forceinline__ void operator()(const f32x4 (&acc)[2][2][4][2], const Unit& u, int wr, int wc, int fr, int fq) const {
        const int row0 = u.pm * BM + wr * 64 + fr; const int col0 = u.pn * HALF + wc * 32 + 8 * fq;
#pragma unroll
        for (int ai = 0; ai < 2; ++ai)
#pragma unroll
            for (int m = 0; m < 4; ++m) { bf16_t* rowp = O + (size_t)(row0 + ai * HALF + m * 16) * ldc + col0;
                f32x4 v0, v1;
#pragma unroll
                for (int j = 0; j < 4; ++j) { v0[j] = siluf_(acc[ai][0][m][0][j]) * acc[ai][1][m][0][j]; v1[j] = siluf_(acc[ai][0][m][1][j]) * acc[ai][1][m][1][j]; }
                u32x4 w; w.x = pk2(v0[0], v0[1]); w.y = pk2(v0[2], v0[3]); w.z = pk2(v1[0], v1[1]); w.w = pk2(v1[2], v1[3]);
                *(u32x4*)rowp = w; }
    }
};
struct EpiMoeDown {
    static constexpr bool PERM = true, AFTER_DRAIN = false;
    bf16_t* Y; const int* lst; const float* lw; const unsigned* cnt; const float* gate;
    __device__ __forceinline__ void operator()(const f32x4 (&acc)[2][2][4][2], const Unit& u, int wr, int wc, int fr, int fq) const {
        const int col0 = u.pn * BM + wc * 32 + 8 * fq; const int n_e = (int)cnt[u.e];
        int tsv[2][4]; float wv[2][4];
#pragma unroll
        for (int ai = 0; ai < 2; ++ai)
#pragma unroll
            for (int m = 0; m < 4; ++m) { const int pos = u.lrow + ai * HALF + wr * 64 + m * 16 + fr; const size_t q = (size_t)u.e * T + (pos < n_e ? pos : 0); tsv[ai][m] = lst[q]; wv[ai][m] = lw[q]; }
#pragma unroll
        for (int ai = 0; ai < 2; ++ai)
#pragma unroll
            for (int mp = 0; mp < 2; ++mp) {
                f32x4 g[2][2][2];
#pragma unroll
                for (int mm = 0; mm < 2; ++mm) { const int m = 2 * mp + mm; const int b = tsv[ai][m] >> 13;
                    const float* gp = gate + (size_t)b * 6144 + col0;
#pragma unroll
                    for (int bj = 0; bj < 2; ++bj) { g[mm][bj][0] = *(const f32x4*)(gp + bj * HALF); g[mm][bj][1] = *(const f32x4*)(gp + bj * HALF + 4); } }
#pragma unroll
                for (int mm = 0; mm < 2; ++mm) { const int m = 2 * mp + mm; const int pos = u.lrow + ai * HALF + wr * 64 + m * 16 + fr;
                    if (pos < n_e) { bf16_t* rowp = Y + (size_t)tsv[ai][m] * D + col0; const float w = wv[ai][m];
#pragma unroll
                        for (int bj = 0; bj < 2; ++bj) { const f32x4 v0 = acc[ai][bj][m][0] * g[mm][bj][0] * w, v1 = acc[ai][bj][m][1] * g[mm][bj][1] * w;
                            u32x4 o; o.x = pk2(v0[0], v0[1]); o.y = pk2(v0[2], v0[3]); o.z = pk2(v1[0], v1[1]); o.w = pk2(v1[2], v1[3]);
                            *(u32x4*)(rowp + bj * HALF) = o; } } }
            }
    }
};

template <class Epi, class Sched, bool ALIGN_EPI, bool GATHER>
__device__ __forceinline__ void gemm_phase(PG8_LAS unsigned char* lds, const Gemm g, const Sched& S, const Epi& E, const int wid) {
    const int lane = opaque_v(lane_id()), tid = wid * 64 + lane, wr = wid >> 2, wc = wid & 3, fr = lane & 15, fq = lane >> 4;
    const int K = g.K, nt = K / BK;
    unsigned voffA[2], voffB[2];
#pragma unroll
    for (int i = 0; i < 2; ++i) { int R, C; stage_rc(tid * 16 + i * 8192, R, C); const int Rb = Epi::PERM ? ((R & ~31) + perm32(R & 31)) : R;
        voffA[i] = (unsigned)(R * K + C) * 2u; voffB[i] = (unsigned)(Rb * K + C) * 2u; }
    const size_t kstep = (size_t)(BK * 2);
    const size_t hstep = (size_t)HALF * K * 2;
    const size_t tstep = 2 * hstep;
    const unsigned ldsw = (unsigned)wid * 1024u;
    const int aoff = lds_byte(wr * 64 + fr, fq * 8), boff = lds_byte(wc * 32 + fr, fq * 8);
#define PG8_SA(b, h) (((b) * 2 + (h)) * HTB)
#define PG8_SB(b, h) ((4 + (b) * 2 + (h)) * HTB)
#define PG8_GL(gp, ldsoff) __builtin_amdgcn_global_load_lds((const unsigned*)(gp), (PG8_LAS unsigned*)(lds + (ldsoff)), 16, 0, 0)
#define PG8_STAGE(bufoff, gbase, voff) do { _Pragma("unroll") for (int _i = 0; _i < 2; ++_i) PG8_GL((const char*)(gbase) + (voff)[_i], (bufoff) + ldsw + _i * 8192); } while (0)
#define PG8_STAGE_A(bufoff, h, kofs, nx) do { if constexpr (GATHER) { _Pragma("unroll") for (int _i = 0; _i < 2; ++_i) PG8_GL((const char*)g.A + (kofs) + vA[h][_i], (bufoff) + ldsw + _i * 8192); } \
        else { const char* _b = ((nx) ? nA : cA) + (size_t)(h) * hstep + (kofs); PG8_STAGE(bufoff, _b, voffA); } } while (0)
#define PG8_GOFF(dst, uu) do { _Pragma("unroll") for (int _h = 0; _h < 2; ++_h) _Pragma("unroll") for (int _i = 0; _i < 2; ++_i) { int _R, _C; stage_rc(tid * 16 + _i * 8192, _R, _C); \
        const int _tok = S.row_index(uu, _h * HALF + _R); dst[_h][_i] = (unsigned)(_tok * K + _C) * 2u; } } while (0)
#define PG8_LDA(dst, b, h) do { _Pragma("unroll") for (int m = 0; m < 4; ++m) _Pragma("unroll") for (int k = 0; k < 2; ++k) dst[m][k] = *(const PG8_LAS bf16x8*)(lds + PG8_SA(b, h) + aoff + m * 2048 + k * 1024); } while (0)
#define PG8_LDB(dst, b, h) do { _Pragma("unroll") for (int n = 0; n < 2; ++n) _Pragma("unroll") for (int k = 0; k < 2; ++k) dst[n][k] = *(const PG8_LAS bf16x8*)(lds + PG8_SB(b, h) + boff + n * 2048 + k * 1024); } while (0)
#define PG8_MMA(ai, bj, At, Bt) do { __builtin_amdgcn_s_setprio(1); _Pragma("unroll") for (int m = 0; m < 4; ++m) _Pragma("unroll") for (int n = 0; n < 2; ++n) _Pragma("unroll") for (int k = 0; k < 2; ++k) \
        acc[ai][bj][m][n] = __builtin_amdgcn_mfma_f32_16x16x32_bf16(Bt[n][k], At[m][k], acc[ai][bj][m][n], 0, 0, 0); __builtin_amdgcn_s_setprio(0); } while (0)
#define PG8_WAIT_V(n) asm volatile("s_waitcnt vmcnt(" #n ")" ::: "memory")
#define PG8_WAIT_L(n) asm volatile("s_waitcnt lgkmcnt(" #n ")" ::: "memory")
#define PG8_BAR __builtin_amdgcn_s_barrier()
#define PG8_SCHED __builtin_amdgcn_sched_barrier(0)
    Unit cur, nxt; int ui = 0;
    if (!S.next(0, cur)) return;
    f32x4 acc[2][2][4][2];
#pragma unroll
    for (int a = 0; a < 2; ++a)
#pragma unroll
        for (int b = 0; b < 2; ++b)
#pragma unroll
            for (int m = 0; m < 4; ++m)
#pragma unroll
                for (int n = 0; n < 2; ++n) acc[a][b][m][n] = (f32x4){0.f, 0.f, 0.f, 0.f};
    bf16x8 At[4][2], B0[2][2], B1[2][2];
    unsigned vA[2][2];
    const char* cA = (const char*)g.A + (GATHER ? (size_t)0 : (size_t)cur.pm * tstep);
    const char* cB = (const char*)g.Bt + ((size_t)cur.e * g.bexp) * 2 + (size_t)cur.pn * tstep;
    const char* nA = cA;
    if constexpr (GATHER) { PG8_GOFF(vA, cur); }
    PG8_STAGE(PG8_SB(0, 0), cB, voffB); PG8_STAGE(PG8_SB(0, 1), cB + hstep, voffB); PG8_STAGE_A(PG8_SA(0, 0), 0, 0, false); PG8_STAGE_A(PG8_SA(0, 1), 1, 0, false);
    if (wr == 1) PG8_BAR;
    PG8_WAIT_V(2); PG8_BAR;
    PG8_STAGE(PG8_SB(1, 0), cB + kstep, voffB); PG8_STAGE_A(PG8_SA(1, 0), 0, kstep, false); PG8_STAGE(PG8_SB(1, 1), cB + hstep + kstep, voffB);
    PG8_WAIT_V(6); PG8_BAR;
    for (;;) {
        const bool has_next = S.next(ui + 1, nxt);
        const char* nB = has_next ? (const char*)g.Bt + ((size_t)nxt.e * g.bexp) * 2 + (size_t)nxt.pn * tstep : cB;
        if constexpr (!GATHER) nA = has_next ? (const char*)g.A + (size_t)nxt.pm * tstep : cA;
        if constexpr (GATHER) { if (has_next) { unsigned _t[2][2]; PG8_GOFF(_t, nxt); *(PG8_LAS u32x4*)(lds + STAGE_BYTES + tid * 16) = (u32x4){_t[0][0], _t[0][1], _t[1][0], _t[1][1]}; } }
        for (int t = 0; t < nt; t += 2) {
            const bool last = (t == nt - 2);
            const size_t k1 = (size_t)(t + 1) * kstep;
            const size_t k2 = last ? (size_t)0 : (size_t)(t + 2) * kstep, k3 = k2 + kstep;
            const char* b2 = last ? nB : cB + (size_t)(t + 2) * kstep; const char* b3 = b2 + kstep;
            PG8_LDB(B0, 0, 0); PG8_LDB(B1, 0, 1); PG8_SCHED; PG8_LDA(At, 0, 0); PG8_STAGE_A(PG8_SA(1, 1), 1, k1, false);
            if constexpr (GATHER) { if (last && has_next) { const u32x4 _v = *(const PG8_LAS u32x4*)(lds + STAGE_BYTES + tid * 16); vA[0][0] = _v.x; vA[0][1] = _v.y; vA[1][0] = _v.z; vA[1][1] = _v.w; } }
            PG8_WAIT_V(8); PG8_WAIT_L(0); PG8_BAR; PG8_MMA(0, 0, At, B0); PG8_MMA(0, 1, At, B1); PG8_BAR; PG8_SCHED;
            PG8_LDA(At, 0, 1); PG8_STAGE(PG8_SB(0, 0), b2, voffB); PG8_STAGE(PG8_SB(0, 1), b2 + hstep, voffB); PG8_STAGE_A(PG8_SA(0, 0), 0, k2, last);
            PG8_WAIT_V(8); PG8_WAIT_L(0); PG8_BAR; PG8_MMA(1, 0, At, B0); PG8_MMA(1, 1, At, B1); PG8_BAR; PG8_SCHED;
            PG8_LDB(B0, 1, 0); PG8_LDB(B1, 1, 1); PG8_SCHED; PG8_LDA(At, 1, 0); PG8_STAGE_A(PG8_SA(0, 1), 1, k2, last);
            PG8_WAIT_V(8); PG8_WAIT_L(0); PG8_BAR; PG8_MMA(0, 0, At, B0); PG8_MMA(0, 1, At, B1); PG8_BAR; PG8_SCHED;
            PG8_LDA(At, 1, 1); PG8_STAGE(PG8_SB(1, 0), b3, voffB); PG8_STAGE(PG8_SB(1, 1), b3 + hstep, voffB); PG8_STAGE_A(PG8_SA(1, 0), 0, k3, last);
            PG8_WAIT_V(8); PG8_WAIT_L(0); PG8_BAR; PG8_MMA(1, 0, At, B0); PG8_MMA(1, 1, At, B1); PG8_BAR; PG8_SCHED;
        }
        if constexpr (ALIGN_EPI) { if (wr == 0) PG8_BAR; }
        E(acc, cur, wr, wc, fr, fq);
        if (!has_next) break;
#pragma unroll
        for (int a = 0; a < 2; ++a)
#pragma unroll
            for (int b = 0; b < 2; ++b)
#pragma unroll
                for (int m = 0; m < 4; ++m)
#pragma unroll
                    for (int n = 0; n < 2; ++n) acc[a][b][m][n] = (f32x4){0.f, 0.f, 0.f, 0.f};
        cur = nxt; cA = nA; cB = nB; ++ui;
        if constexpr (ALIGN_EPI) { if (wr == 1) PG8_BAR; }
    }
    PG8_WAIT_V(0);
    if constexpr (!ALIGN_EPI) { if (wr == 0) PG8_BAR; }
    PG8_BAR;
#undef PG8_SA
#undef PG8_SB
#undef PG8_GL
#undef PG8_STAGE
#undef PG8_STAGE_A
#undef PG8_GOFF
#undef PG8_LDA
#undef PG8_LDB
#undef PG8_MMA
#undef PG8_WAIT_V
#undef PG8_WAIT_L
#undef PG8_BAR
#undef PG8_SCHED
}
}

#define XB_TMO      128
#define XB_XCNT(j)  (256  + 64 * (j))
#define XB_XSUB(j)  (1280 + 64 * (j))
#define XB_XGEN(j)  (2304 + 64 * (j))
#define XB_TOP      3328
#define XB_TOPGEN   3392
#define XCD_BAR_WORDS 3456
#define XB_SPIN_CAP (1u << 18)
__device__ __forceinline__ unsigned xb_ld(unsigned* p)              { return __hip_atomic_load(p, __ATOMIC_RELAXED, __HIP_MEMORY_SCOPE_AGENT); }
__device__ __forceinline__ unsigned xb_add(unsigned* p, unsigned v) { return __hip_atomic_fetch_add(p, v, __ATOMIC_RELAXED, __HIP_MEMORY_SCOPE_AGENT); }
__device__ __forceinline__ unsigned xb_xcc_id() { return (unsigned)__builtin_amdgcn_s_getreg((3 << 11) | 20) & 0xFu; }
#define XB_SPIN(cond, bar) do { unsigned _sp = 0; while (cond) { __builtin_amdgcn_s_sleep(1); \
    if ((++_sp & 255u) == 0u) { if (xb_ld(&(bar)[XB_TMO])) break; if (_sp > XB_SPIN_CAP) { atomicAdd(&(bar)[XB_TMO], 1u); break; } } } } while (0)
struct XcdBarrier { unsigned* bar; unsigned x; volatile LAS unsigned* st; int wv; };
__device__ __forceinline__ XcdBarrier xcd_barrier_post(unsigned* bar, volatile LAS unsigned* st, int wv) {
    XcdBarrier b; b.bar = bar; b.x = xb_xcc_id(); b.st = st; b.wv = wv;
    if (wv == 0 && lane_id() == 0) (void)xb_add(&bar[XB_XCNT(b.x)], 1u);
    return b;
}
__device__ __forceinline__ void xcd_barrier_complete(unsigned* bar, unsigned x, unsigned& nloc, unsigned& nx) {
    const unsigned G = gridDim.x * gridDim.y * gridDim.z;
    unsigned sum, cnt, mine, sp = 0u;
    for (;;) {
        sum = 0u; cnt = 0u; mine = 0u;
#pragma unroll
        for (unsigned j = 0; j < 16; ++j) { const unsigned c = xb_ld(&bar[XB_XCNT(j)]); sum += c; cnt += (c > 0u) ? 1u : 0u; mine = (j == x) ? c : mine; }
        if (sum == G) break;
        __builtin_amdgcn_s_sleep(1);
        if ((++sp & 255u) == 0u) { if (xb_ld(&bar[XB_TMO])) break; if (sp > XB_SPIN_CAP) { atomicAdd(&bar[XB_TMO], 1u); break; } }
    }
    nloc = mine > 0u ? mine : 1u; nx = cnt > 0u ? cnt : 1u;
}
__device__ __forceinline__ void xcd_barrier(const XcdBarrier& b) {
    asm volatile("s_waitcnt vmcnt(0)" ::: "memory");
    __syncthreads();
    if (b.wv == 0 && lane_id() == 0) {
        unsigned* bar = b.bar;
        __builtin_amdgcn_s_waitcnt(0);
        unsigned nloc = b.st[0], nx = b.st[1];
        if (nloc == 0u) { xcd_barrier_complete(bar, b.x, nloc, nx); b.st[0] = nloc; b.st[1] = nx; }
        const unsigned old = xb_add(&bar[XB_XSUB(b.x)], 1u);
        const unsigned gen = old / nloc;
        if (old + 1u == (gen + 1u) * nloc) {
            __builtin_amdgcn_fence(__ATOMIC_RELEASE, "agent");
            asm volatile("s_waitcnt vmcnt(0)" ::: "memory");
            const unsigned og = xb_add(&bar[XB_TOP], 1u);
            const unsigned tg = og / nx;
            if (og + 1u == (tg + 1u) * nx) xb_add(&bar[XB_TOPGEN], 1u);
            else XB_SPIN(xb_ld(&bar[XB_TOPGEN]) == tg, bar);
            __builtin_amdgcn_fence(__ATOMIC_ACQUIRE, "agent");
            xb_add(&bar[XB_XGEN(b.x)], 1u);
            asm volatile("s_waitcnt vmcnt(0)" ::: "memory");
        } else {
            XB_SPIN(xb_ld(&bar[XB_XGEN(b.x)]) == gen, bar);
            __builtin_amdgcn_fence(__ATOMIC_ACQUIRE, "agent");
            asm volatile("s_waitcnt vmcnt(0)" ::: "memory");
        }
    }
    __syncthreads();
}

struct Args { const float* in[25]; float* out; unsigned char* ws; int ph_lo, ph_hi; };
typedef const __attribute__((address_space(4))) unsigned char* kseg_t;
__device__ __forceinline__ kseg_t kseg() { kseg_t p = (kseg_t)__builtin_amdgcn_kernarg_segment_ptr(); asm volatile("" : "+s"(p)); return p; }
__device__ __forceinline__ const float* karg(int i) { return *(const float* const __attribute__((address_space(4)))*)(kseg() + 8 * i); }
__device__ __forceinline__ float* kout() { return *(float* const __attribute__((address_space(4)))*)(kseg() + 8 * 25); }
__device__ __forceinline__ unsigned char* kws() { return *(unsigned char* const __attribute__((address_space(4)))*)(kseg() + 8 * 26); }
enum { I_X = 0, I_C, I_ADAW, I_ADAB, I_N1W, I_N2W, I_FNW, I_MWIN, I_MIB, I_MFB, I_MCW, I_MCB, I_MNW, I_MWOUT, I_HWIN, I_HLB, I_HNW, I_HWOUT, I_FG, I_FU, I_FD, I_RT, I_EG, I_EU, I_ED };

__device__ __forceinline__ void tr_item(const float* W, int ldw, int k0, int n0, bf16_t* WT, int ldt, int dst_row0, LAS float* scr, int lane) {
    float wv[32];
#pragma unroll
    for (int i = 0; i < 32; ++i) { const int kk = 2 * i + (lane >> 5); wv[i] = W[(size_t)(k0 + kk) * ldw + n0 + (lane & 31)]; }
#pragma unroll
    for (int i = 0; i < 32; ++i) { const int kk = 2 * i + (lane >> 5); scr[kk * 33 + (lane & 31)] = wv[i]; }
    asm volatile("s_waitcnt lgkmcnt(0)" ::: "memory");
    const int c = lane & 7;
#pragma unroll
    for (int j = 0; j < 4; ++j) { const int n = (lane >> 3) + 8 * j; const LAS float* s = scr + (8 * c) * 33 + n;
        u32x4 o; o.x = pk2(s[0 * 33], s[1 * 33]); o.y = pk2(s[2 * 33], s[3 * 33]); o.z = pk2(s[4 * 33], s[5 * 33]); o.w = pk2(s[6 * 33], s[7 * 33]);
        *(u32x4*)(WT + (size_t)(dst_row0 + n) * ldt + k0 + 8 * c) = o; }
    asm volatile("s_waitcnt lgkmcnt(0)" ::: "memory");
}
__device__ __forceinline__ void tr_matrix_item(const float* W, int K, int ldw, int ncols, bf16_t* WT, int mode, int item, LAS float* scr, int lane) {
    const int nblk = ncols / 32, kb = item / nblk, nb = item % nblk, n0 = nb * 32;
    const int dr = (mode == 0) ? n0 : (mode == 3) ? (n0 + (n0 < 1024 ? 0 : (n0 < 2048 ? 1024 : -1024))) : (mode == 4) ? (n0 + (n0 < 2048 ? 0 : (n0 < 3072 ? 1024 : -1024)))
                                     : ((n0 >> 7) * 256 + (n0 & 127) + (mode == 2 ? 128 : 0));
    tr_item(W, ldw, kb * 64, n0, WT, K, dr, scr, lane);
}
constexpr int CV_MIN = 16 * 96, CV_SQ = 16 * 32, CV_FG1 = 16 * 88, CV_FD1 = 44 * 32, CV_HIN = 16 * 128, CV_EG1 = 16 * 44, CV_ED1 = 22 * 32;
constexpr int CV_PER_LP = CV_MIN + CV_SQ + 2 * CV_FG1 + CV_FD1 + CV_HIN + CV_SQ + 8 * (2 * CV_EG1 + CV_ED1);
constexpr int CV_FIRST = CV_MIN + CV_SQ + 2 * CV_FG1 + CV_FD1;
constexpr int CV_TAIL1 = (CV_PER_LP * 2) / 5;
__device__ __forceinline__ void convert_items(LAS unsigned char* lds, int tid, int vb, int NV, int it_lo, int it_hi) {
    tid = opaque_v(tid); vb = opaque_s(vb);
    const int lane = tid & 63, wave = __builtin_amdgcn_readfirstlane(tid >> 6);
    unsigned char* ws = kws();
    LAS float* scr = (LAS float*)(lds + wave * 8448);
    constexpr int I_MIN = CV_MIN, I_SQ = CV_SQ, I_FG1 = CV_FG1, I_FD1 = CV_FD1, I_HIN = CV_HIN, I_EG1 = CV_EG1, I_ED1 = CV_ED1;
    constexpr int PER_LP = CV_PER_LP;
    const int gw = vb * 8 + wave, NGW = NV * 8;
    for (int it = it_lo + gw; it < it_hi; it += NGW) {
        const int j = it / PER_LP; int r = it % PER_LP;
        unsigned char* wb = ws + WS_WGT + (size_t)j * LP_BYTES;
        if (r < I_MIN) { tr_matrix_item(karg(I_MWIN) + (size_t)j * 1024 * MPROJ, 1024, MPROJ, MPROJ_G, (bf16_t*)(wb + W_MIN), 3, r, scr, lane); continue; } r -= I_MIN;
        if (r < I_SQ) { tr_matrix_item(karg(I_MWOUT) + (size_t)j * 1024 * 1024, 1024, 1024, 1024, (bf16_t*)(wb + W_MOUT), 0, r, scr, lane); continue; } r -= I_SQ;
        if (r < I_FG1) { tr_matrix_item(karg(I_FG) + (size_t)j * 1024 * DFF, 1024, DFF, DFF, (bf16_t*)(wb + W_FGU), 1, r, scr, lane); continue; } r -= I_FG1;
        if (r < I_FG1) { tr_matrix_item(karg(I_FU) + (size_t)j * 1024 * DFF, 1024, DFF, DFF, (bf16_t*)(wb + W_FGU), 2, r, scr, lane); continue; } r -= I_FG1;
        if (r < I_FD1) { tr_matrix_item(karg(I_FD) + (size_t)j * DFF * 1024, DFF, 1024, 1024, (bf16_t*)(wb + W_FD), 0, r, scr, lane); continue; } r -= I_FD1;
        if (r < I_HIN) { tr_matrix_item(karg(I_HWIN) + (size_t)j * 1024 * HPROJ, 1024, HPROJ, HPROJ, (bf16_t*)(wb + W_HIN), 4, r, scr, lane); continue; } r -= I_HIN;
        if (r < I_SQ) { tr_matrix_item(karg(I_HWOUT) + (size_t)j * 1024 * 1024, 1024, 1024, 1024, (bf16_t*)(wb + W_HOUT), 0, r, scr, lane); continue; } r -= I_SQ;
        const int e = r / (2 * I_EG1 + I_ED1); r -= e * (2 * I_EG1 + I_ED1);
        if (r < I_EG1) { tr_matrix_item(karg(I_EG) + ((size_t)j * 8 + e) * 1024 * DFE, 1024, DFE, DFE, (bf16_t*)(wb + W_EGU) + (size_t)e * 2816 * 1024, 1, r, scr, lane); continue; } r -= I_EG1;
        if (r < I_EG1) { tr_matrix_item(karg(I_EU) + ((size_t)j * 8 + e) * 1024 * DFE, 1024, DFE, DFE, (bf16_t*)(wb + W_EGU) + (size_t)e * 2816 * 1024, 2, r, scr, lane); continue; } r -= I_EG1;
        tr_matrix_item(karg(I_ED) + ((size_t)j * 8 + e) * DFE * 1024, DFE, 1024, 1024, (bf16_t*)(wb + W_ED) + (size_t)e * 1024 * DFE, 0, r, scr, lane);
    }
}

__device__ __forceinline__ void tail_convert(LAS unsigned char* lds, int tid, int c, int G, int nwg, int it_lo, int it_hi) {
    const int rounds = (nwg + G - 1) / G, n_last = nwg - G * (rounds - 1);
    if (n_last >= G || rounds == 0) convert_items(lds, tid, c, G, it_lo, it_hi);
    else if (c >= n_last) convert_items(lds, tid, c - n_last, G - n_last, it_lo, it_hi);
}
__device__ __forceinline__ void p0_phase(LAS unsigned char* lds, int tid, int bid, int G) {
    tid = opaque_v(tid); bid = opaque_s(bid);
    const int lane = tid & 63, wave = __builtin_amdgcn_readfirstlane(tid >> 6);
    unsigned char* ws = kws();
    LAS float* cond = (LAS float*)(lds + 69632);
    LAS float* red = (LAS float*)(lds + 102400);
    for (int i = tid; i < 8 * 1024; i += 512) cond[i] = siluf_(karg(I_C)[i]);
    __syncthreads();
    float* mod = (float*)(ws + WS_MOD);
    for (int item = bid; item < 256; item += G) {
        const int L = item >> 6, n0 = (item & 63) * 96;
        float acc[8][2];
#pragma unroll
        for (int b = 0; b < 8; ++b) { acc[b][0] = 0.f; acc[b][1] = 0.f; }
        if (lane < 48) {
            const float* wp = karg(I_ADAW) + ((size_t)L * 1024 + wave * 128) * 6144 + n0 + 2 * lane;
#pragma unroll 8
            for (int k = 0; k < 128; ++k) { const f32x2 wv = *(const f32x2*)(wp + (size_t)k * 6144);
#pragma unroll
                for (int b = 0; b < 8; ++b) { const float cv = cond[b * 1024 + wave * 128 + k]; acc[b][0] += cv * wv.x; acc[b][1] += cv * wv.y; } }
#pragma unroll
            for (int b = 0; b < 8; ++b) { red[(wave * 8 + b) * 96 + 2 * lane] = acc[b][0]; red[(wave * 8 + b) * 96 + 2 * lane + 1] = acc[b][1]; }
        }
        __syncthreads();
        for (int o = tid; o < 768; o += 512) { const int b = o / 96, n = o % 96; float s = 0.f;
#pragma unroll
            for (int w = 0; w < 8; ++w) s += red[(w * 8 + b) * 96 + n];
            mod[((size_t)L * 8 + b) * 6144 + n0 + n] = s + karg(I_ADAB)[L * 6144 + n0 + n]; }
        __syncthreads();
    }
    if (bid == 0) { float* lb = (float*)(ws + WS_LB); for (int d = tid; d < 1024; d += 512) lb[d] = sigmoidf_(karg(I_HLB)[1024 + d] - karg(I_HLB)[d]); }
    for (int i = bid * 512 + tid; i < 2 * 16 * 1024 + 2 * 8 * 1024; i += G * 512) {
        if (i < 2 * 16 * 1024) { const int j = i >> 14, g = (i >> 10) & 15, k = i & 1023;
            ((float*)(ws + WS_WGT + (size_t)j * LP_BYTES + W_MGATE))[g * 1024 + k] = karg(I_MWIN)[((size_t)j * 1024 + k) * MPROJ + MPROJ_G + g]; }
        else { const int i2 = i - 2 * 16 * 1024; const int j = i2 >> 13, e = (i2 >> 10) & 7, k = i2 & 1023;
            ((float*)(ws + WS_WGT + (size_t)j * LP_BYTES + W_ROUT))[e * 1024 + k] = karg(I_RT)[((size_t)j * 1024 + k) * 8 + e]; }
    }
    convert_items(lds, tid, bid, G, 0, CV_PER_LP);
}

template <int MODE, bool COMBINE, bool XF32 = false>
__device__ __forceinline__ void norm_phase(LAS unsigned char* lds, int tid, int bid, int G, const void* xsrc, bf16_t* xdst, const bf16_t* Y,
                                           const float* normw, const float* shift, const float* scale, bf16_t* hn,
                                           const float* Wx  , const float* ibias, const float* fbias, float* li, float* lf,
                                           unsigned* gcnt, int* lst_tok, float* lst_w) {
    tid = opaque_v(tid); bid = opaque_s(bid);
    const int lane = tid & 63, wave = __builtin_amdgcn_readfirstlane(tid >> 6);
    constexpr int NX = (MODE == 1) ? 16 : 8;
    LAS float* wl = (LAS float*)lds;
    LAS unsigned* lcnt = (LAS unsigned*)(lds + 65536);
    LAS unsigned* gbase = (LAS unsigned*)(lds + 65536 + 64);
    LAS int* rinfo = (LAS int*)(lds + 65536 + 128);
    float gbias = 0.f;
    if (MODE == 1) { const int g = (lane >> 2) & 15; gbias = (g < 8) ? ibias[g] : fbias[g - 8]; }
    if (MODE != 0) { for (int i = tid; i < NX * 1024; i += 512) { const int g = i >> 10, r = i & 1023, m = r >> 8, ln = (r >> 2) & 63, e = r & 3; wl[i] = Wx[g * 1024 + 8 * ln + 512 * (m >> 1) + 4 * (m & 1) + e]; } }
    __syncthreads();
    for (int blk = bid; blk < T / 128; blk += G) {
        const int b = blk >> 5;
        f32x4 gw[4], sh[4];
#pragma unroll
        for (int j = 0; j < 4; ++j) { const int col = 8 * lane + 512 * (j >> 1) + 4 * (j & 1); const f32x4 w = *(const f32x4*)(normw + col), sc = *(const f32x4*)(scale + (size_t)b * 6144 + col);
            gw[j] = w * (1.f + sc); sh[j] = *(const f32x4*)(shift + (size_t)b * 6144 + col); }
        if (MODE == 2) { if (tid < 8) lcnt[tid] = 0u; __syncthreads(); }
        f32x4 pxf[4]; u32x4 pxb[2], py0[2], py1[2];
#define NP_LOAD(rw) do { \
            if (XF32) { _Pragma("unroll") for (int j = 0; j < 4; ++j) pxf[j] = *(const f32x4*)((const float*)xsrc + (rw) * D + 8 * lane + 512 * (j >> 1) + 4 * (j & 1)); } \
            else { _Pragma("unroll") for (int jj = 0; jj < 2; ++jj) pxb[jj] = *(const u32x4*)((const bf16_t*)xsrc + (rw) * XP + 8 * lane + 512 * jj); } \
            if (COMBINE) { _Pragma("unroll") for (int jj = 0; jj < 2; ++jj) { py0[jj] = *(const u32x4*)(Y + ((rw) * 2) * D + 8 * lane + 512 * jj); py1[jj] = *(const u32x4*)(Y + ((rw) * 2 + 1) * D + 8 * lane + 512 * jj); } } } while (0)
        NP_LOAD((size_t)blk * 128 + wave * 16);
        f32x4 vp[4];
        for (int i = 0; i < 16; ++i) {
            const int rl = wave * 16 + i; const size_t row = (size_t)blk * 128 + rl;
            f32x4 v[4]; float s = 0.f; u32x4 cy0[2], cy1[2];
            if (XF32) {
#pragma unroll
                for (int j = 0; j < 4; ++j) v[j] = pxf[j];
            } else {
#pragma unroll
                for (int jj = 0; jj < 2; ++jj) { v[2 * jj] = (f32x4){bf2f_lo(pxb[jj].x), bf2f_hi(pxb[jj].x), bf2f_lo(pxb[jj].y), bf2f_hi(pxb[jj].y)}; v[2 * jj + 1] = (f32x4){bf2f_lo(pxb[jj].z), bf2f_hi(pxb[jj].z), bf2f_lo(pxb[jj].w), bf2f_hi(pxb[jj].w)}; }
            }
            if (COMBINE) {
#pragma unroll
                for (int jj = 0; jj < 2; ++jj) { cy0[jj] = py0[jj]; cy1[jj] = py1[jj]; }
            }
            { const size_t rn = (size_t)blk * 128 + wave * 16 + (i < 15 ? i + 1 : i); NP_LOAD(rn); }
            if (COMBINE) {
#pragma unroll
                for (int jj = 0; jj < 2; ++jj) { const u32x4 y0 = cy0[jj], y1 = cy1[jj];
                    v[2 * jj].x += bf2f_lo(y0.x) + bf2f_lo(y1.x); v[2 * jj].y += bf2f_hi(y0.x) + bf2f_hi(y1.x); v[2 * jj].z += bf2f_lo(y0.y) + bf2f_lo(y1.y); v[2 * jj].w += bf2f_hi(y0.y) + bf2f_hi(y1.y);
                    v[2 * jj + 1].x += bf2f_lo(y0.z) + bf2f_lo(y1.z); v[2 * jj + 1].y += bf2f_hi(y0.z) + bf2f_hi(y1.z); v[2 * jj + 1].z += bf2f_lo(y0.w) + bf2f_lo(y1.w); v[2 * jj + 1].w += bf2f_hi(y0.w) + bf2f_hi(y1.w);
                    u32x4 xo4; xo4.x = pk2(v[2 * jj].x, v[2 * jj].y); xo4.y = pk2(v[2 * jj].z, v[2 * jj].w); xo4.z = pk2(v[2 * jj + 1].x, v[2 * jj + 1].y); xo4.w = pk2(v[2 * jj + 1].z, v[2 * jj + 1].w);
                    *(u32x4*)(xdst + row * XP + 8 * lane + 512 * jj) = xo4; }
            }
#pragma unroll
            for (int j = 0; j < 4; ++j) s += (v[j].x * v[j].x + v[j].y * v[j].y) + (v[j].z * v[j].z + v[j].w * v[j].w);
            const float rstd = rsqrtf(wave_sum(s) * (1.f / D) + EPS);
#pragma unroll
            for (int j = 0; j < 4; ++j) v[j] = v[j] * rstd * gw[j] + sh[j];
#pragma unroll
            for (int jj = 0; jj < 2; ++jj) { u32x4 o; o.x = pk2(v[2 * jj].x, v[2 * jj].y); o.y = pk2(v[2 * jj].z, v[2 * jj].w); o.z = pk2(v[2 * jj + 1].x, v[2 * jj + 1].y); o.w = pk2(v[2 * jj + 1].z, v[2 * jj + 1].w);
                *(u32x4*)(hn + row * D + 8 * lane + 512 * jj) = o; }
            if (MODE != 0) {
                if ((i & 1) == 0) {
#pragma unroll
                    for (int j = 0; j < 4; ++j) vp[j] = v[j];
                } else {
                    float pa[NX], pb[NX];
#pragma unroll
                    for (int g = 0; g < NX; ++g) { f32x2 a0 = (f32x2){0.f, 0.f}, a1 = a0;
#pragma unroll
                        for (int j = 0; j < 4; ++j) { const f32x4 w = *(const LAS f32x4*)(wl + g * 1024 + 4 * lane + 256 * j); const f32x2 wlo = (f32x2){w.x, w.y}, whi = (f32x2){w.z, w.w};
                            a0 = a0 + (f32x2){vp[j].x, vp[j].y} * wlo; a0 = a0 + (f32x2){vp[j].z, vp[j].w} * whi;
                            a1 = a1 + (f32x2){v[j].x, v[j].y} * wlo; a1 = a1 + (f32x2){v[j].z, v[j].w} * whi; }
                        pa[g] = a0.x + a0.y; pb[g] = a1.x + a1.y; }
                    const bool b5 = (lane & 32) != 0, b4 = (lane & 16) != 0, b3 = (lane & 8) != 0, b2 = (lane & 4) != 0;
                    float ra, rb;
                    if (NX == 16) {
                        float qa[8], qb[8];
#pragma unroll
                        for (int k = 0; k < 8; ++k) { qa[k] = (b5 ? pa[8 + k] : pa[k]) + __shfl_xor(b5 ? pa[k] : pa[8 + k], 32); qb[k] = (b5 ? pb[8 + k] : pb[k]) + __shfl_xor(b5 ? pb[k] : pb[8 + k], 32); }
                        float ta[4], tb[4];
#pragma unroll
                        for (int k = 0; k < 4; ++k) { ta[k] = (b4 ? qa[4 + k] : qa[k]) + __shfl_xor(b4 ? qa[k] : qa[4 + k], 16); tb[k] = (b4 ? qb[4 + k] : qb[k]) + __shfl_xor(b4 ? qb[k] : qb[4 + k], 16); }
                        float ua[2], ub[2];
#pragma unroll
                        for (int k = 0; k < 2; ++k) { ua[k] = (b3 ? ta[2 + k] : ta[k]) + __shfl_xor(b3 ? ta[k] : ta[2 + k], 8); ub[k] = (b3 ? tb[2 + k] : tb[k]) + __shfl_xor(b3 ? tb[k] : tb[2 + k], 8); }
                        ra = (b2 ? ua[1] : ua[0]) + __shfl_xor(b2 ? ua[0] : ua[1], 4); rb = (b2 ? ub[1] : ub[0]) + __shfl_xor(b2 ? ub[0] : ub[1], 4);
                        ra += __shfl_xor(ra, 2); rb += __shfl_xor(rb, 2); ra += __shfl_xor(ra, 1); rb += __shfl_xor(rb, 1);
                    } else {
                        float ta[4], tb[4];
#pragma unroll
                        for (int k = 0; k < 4; ++k) { ta[k] = (b5 ? pa[4 + k] : pa[k]) + __shfl_xor(b5 ? pa[k] : pa[4 + k], 32); tb[k] = (b5 ? pb[4 + k] : pb[k]) + __shfl_xor(b5 ? pb[k] : pb[4 + k], 32); }
                        float ua[2], ub[2];
#pragma unroll
                        for (int k = 0; k < 2; ++k) { ua[k] = (b4 ? ta[2 + k] : ta[k]) + __shfl_xor(b4 ? ta[k] : ta[2 + k], 16); ub[k] = (b4 ? tb[2 + k] : tb[k]) + __shfl_xor(b4 ? tb[k] : tb[2 + k], 16); }
                        ra = (b3 ? ua[1] : ua[0]) + __shfl_xor(b3 ? ua[0] : ua[1], 8); rb = (b3 ? ub[1] : ub[0]) + __shfl_xor(b3 ? ub[0] : ub[1], 8);
                        ra += __shfl_xor(ra, 4); rb += __shfl_xor(rb, 4); ra += __shfl_xor(ra, 2); rb += __shfl_xor(rb, 2); ra += __shfl_xor(ra, 1); rb += __shfl_xor(rb, 1);
                    }
                    if (MODE == 1) {
                        if ((lane & 3) == 0) { const int g = lane >> 2;
#pragma unroll
                            for (int q = 0; q < 2; ++q) { const size_t rw = row - 1 + q; const float a = (q ? rb : ra) + gbias;
                                if (g < 8) li[rw * 8 + g] = 15.f * tanhf(a * (1.f / 15.f));
                                else lf[rw * 8 + g - 8] = fminf(a, 0.f) - log1pf(expf(-fabsf(a))); } }
                    }
                    if (MODE == 2) {
#pragma unroll
                        for (int q = 0; q < 2; ++q) { const float rr = q ? rb : ra;
                            float lg[8];
#pragma unroll
                            for (int e = 0; e < 8; ++e) lg[e] = __builtin_bit_cast(float, __builtin_amdgcn_readlane(__builtin_bit_cast(int, rr), 8 * e));
                            int e0 = 0; float m0 = lg[0];
#pragma unroll
                            for (int e = 1; e < 8; ++e) if (lg[e] > m0) { m0 = lg[e]; e0 = e; }
                            int e1 = -1; float m1 = -3.0e38f;
#pragma unroll
                            for (int e = 0; e < 8; ++e) if (e != e0 && lg[e] > m1) { m1 = lg[e]; e1 = e; }
                            if (lane == 0) { const float w0 = 1.f / (1.f + __expf(m1 - m0)), w1 = 1.f - w0;
                                const unsigned p0 = __hip_atomic_fetch_add(lcnt + e0, 1u, __ATOMIC_RELAXED, __HIP_MEMORY_SCOPE_WORKGROUP), p1 = __hip_atomic_fetch_add(lcnt + e1, 1u, __ATOMIC_RELAXED, __HIP_MEMORY_SCOPE_WORKGROUP);
                                LAS int* ri = rinfo + (rl - 1 + q) * 6; ri[0] = e0; ri[1] = (int)p0; ri[2] = __builtin_bit_cast(int, w0); ri[3] = e1; ri[4] = (int)p1; ri[5] = __builtin_bit_cast(int, w1); } }
                    }
                }
            }
        }
        if (MODE == 2) {
            __syncthreads();
            if (tid < 8) gbase[tid] = __hip_atomic_fetch_add(gcnt + tid, lcnt[tid], __ATOMIC_RELAXED, __HIP_MEMORY_SCOPE_AGENT);
            __syncthreads();
            if (tid < 128) { const LAS int* ri = rinfo + tid * 6; const int tok = blk * 128 + tid;
                const int e0 = ri[0], e1 = ri[3]; const size_t q0 = (size_t)e0 * T + gbase[e0] + ri[1], q1 = (size_t)e1 * T + gbase[e1] + ri[4];
                lst_tok[q0] = tok * 2; lst_w[q0] = __builtin_bit_cast(float, ri[2]); lst_tok[q1] = tok * 2 + 1; lst_w[q1] = __builtin_bit_cast(float, ri[5]); }
            __syncthreads();
        }
    }
}
#undef NP_LOAD
template <bool COMBINE>
__device__ __forceinline__ void final_phase(int tid, int bid, int G, float* x, const bf16_t* Y, const float* fw) {
    tid = opaque_v(tid); bid = opaque_s(bid);
    const int lane = tid & 63, wave = tid >> 6;
    f32x4 w4[4];
#pragma unroll
    for (int j = 0; j < 4; ++j) w4[j] = *(const f32x4*)(fw + 8 * lane + 512 * (j >> 1) + 4 * (j & 1));
    u32x4 pxb[2], py0[2], py1[2];
#define FP_LOAD(rw) do { _Pragma("unroll") for (int jj = 0; jj < 2; ++jj) { pxb[jj] = *(const u32x4*)((const bf16_t*)x + (rw) * XP + 8 * lane + 512 * jj); \
        if (COMBINE) { py0[jj] = *(const u32x4*)(Y + ((rw) * 2) * D + 8 * lane + 512 * jj); py1[jj] = *(const u32x4*)(Y + ((rw) * 2 + 1) * D + 8 * lane + 512 * jj); } } } while (0)
    { const size_t r0 = (size_t)bid * 8 + wave; FP_LOAD((r0 < (size_t)T ? r0 : (size_t)0)); }
    for (size_t row = (size_t)bid * 8 + wave; row < (size_t)T; row += (size_t)G * 8) {
        f32x4 v[4]; float s = 0.f; u32x4 cy0[2], cy1[2];
#pragma unroll
        for (int jj = 0; jj < 2; ++jj) { v[2 * jj] = (f32x4){bf2f_lo(pxb[jj].x), bf2f_hi(pxb[jj].x), bf2f_lo(pxb[jj].y), bf2f_hi(pxb[jj].y)}; v[2 * jj + 1] = (f32x4){bf2f_lo(pxb[jj].z), bf2f_hi(pxb[jj].z), bf2f_lo(pxb[jj].w), bf2f_hi(pxb[jj].w)};
            if (COMBINE) { cy0[jj] = py0[jj]; cy1[jj] = py1[jj]; } }
        { const size_t rn = row + (size_t)G * 8; FP_LOAD((rn < (size_t)T ? rn : row)); }
        if (COMBINE) {
#pragma unroll
            for (int jj = 0; jj < 2; ++jj) { const u32x4 y0 = cy0[jj], y1 = cy1[jj];
                v[2 * jj].x += bf2f_lo(y0.x) + bf2f_lo(y1.x); v[2 * jj].y += bf2f_hi(y0.x) + bf2f_hi(y1.x); v[2 * jj].z += bf2f_lo(y0.y) + bf2f_lo(y1.y); v[2 * jj].w += bf2f_hi(y0.y) + bf2f_hi(y1.y);
                v[2 * jj + 1].x += bf2f_lo(y0.z) + bf2f_lo(y1.z); v[2 * jj + 1].y += bf2f_hi(y0.z) + bf2f_hi(y1.z); v[2 * jj + 1].z += bf2f_lo(y0.w) + bf2f_lo(y1.w); v[2 * jj + 1].w += bf2f_hi(y0.w) + bf2f_hi(y1.w); }
        }
#pragma unroll
        for (int j = 0; j < 4; ++j) s += (v[j].x * v[j].x + v[j].y * v[j].y) + (v[j].z * v[j].z + v[j].w * v[j].w);
        const float rstd = rsqrtf(wave_sum(s) * (1.f / D) + EPS);
#pragma unroll
        for (int j = 0; j < 4; ++j) *(f32x4*)(x + row * D + 8 * lane + 512 * (j >> 1) + 4 * (j & 1)) = v[j] * rstd * w4[j];
    }
#undef FP_LOAD
}

#define MK_DPP_F(idv, v, ctrl, rmask) __builtin_bit_cast(float, __builtin_amdgcn_update_dpp(__builtin_bit_cast(int, (float)(idv)), __builtin_bit_cast(int, (float)(v)), (ctrl), (rmask), 0xf, false))
__device__ __forceinline__ float wave_scan_add(float v) {
    v += MK_DPP_F(0.f, v, 0x111, 0xf); v += MK_DPP_F(0.f, v, 0x112, 0xf); v += MK_DPP_F(0.f, v, 0x114, 0xf); v += MK_DPP_F(0.f, v, 0x118, 0xf);
    v += MK_DPP_F(0.f, v, 0x142, 0xa); v += MK_DPP_F(0.f, v, 0x143, 0xc);
    return v;
}
__device__ __forceinline__ float wave_scan_max(float v) {
    constexpr float NI = -3.0e38f;
    v = fmaxf(v, MK_DPP_F(NI, v, 0x111, 0xf)); v = fmaxf(v, MK_DPP_F(NI, v, 0x112, 0xf)); v = fmaxf(v, MK_DPP_F(NI, v, 0x114, 0xf)); v = fmaxf(v, MK_DPP_F(NI, v, 0x118, 0xf));
    v = fmaxf(v, MK_DPP_F(NI, v, 0x142, 0xa)); v = fmaxf(v, MK_DPP_F(NI, v, 0x143, 0xc));
    return v;
}
struct MpPf { u32x4 pq, pk, phq, phk; f32x4 pg4; };
__device__ __forceinline__ void mp_load(MpPf& P, int itx, int tid, int lane, const bf16_t* QKR, const bf16_t* OGT, const bf16_t* VTT, const float* LIb, const float* LFb) {
    const int b_ = itx >> 9, h_ = (itx >> 6) & 7, c_ = itx & 63; const size_t m0_ = (size_t)b_ * SEQ + (size_t)c_ * 64; const size_t ib_ = (size_t)itx * 8192 + tid * 8;
    P.pq = *(const u32x4*)(QKR + ib_); P.pk = *(const u32x4*)(QKR + ib_ + 4096);
    { const size_t hb_ = (itx > 0 ? ib_ - 8192 : ib_) + (size_t)(tid < 24 ? 61 * 64 : 0); P.phq = *(const u32x4*)(QKR + hb_); P.phk = *(const u32x4*)(QKR + hb_ + 4096);
      if (c_ == 0) { P.phq = (u32x4){0u, 0u, 0u, 0u}; P.phk = P.phq; } }
    { const float* gp_ = (tid < 64) ? LIb : LFb; P.pg4 = *(const f32x4*)(gp_ + (m0_ + (tid & 63)) * 8 + 4 * (h_ >> 2)); }
}
__device__ __forceinline__ void mlstm_prep(LAS unsigned char* lds, int tid, int bid, int G, const bf16_t* QKR, bf16_t* OGT, const bf16_t* VTT, const float* LIb, const float* LFb, f32x4* SCT, f32x4* SCI,
                                           const float* convw, const float* convb, const float* normw, bf16_t* QKT, bf16_t* U) {
    tid = opaque_v(tid); bid = opaque_s(bid);
    const int lane = tid & 63, w = __builtin_amdgcn_readfirstlane(tid >> 6), l15 = lane & 15, q4 = lane >> 4;
    LAS bf16_t* QR = (LAS bf16_t*)(lds + 0);
    LAS bf16_t* KR = (LAS bf16_t*)(lds + 8704);
    LAS bf16_t* Qc = (LAS bf16_t*)(lds + 17408);
    LAS bf16_t* Kc = (LAS bf16_t*)(lds + 26624);
    LAS bf16_t* KT = (LAS bf16_t*)(lds + 35840);
    LAS bf16_t* VT = (LAS bf16_t*)(lds + 45056);
    LAS bf16_t* Sm = (LAS bf16_t*)(lds + 63488);
    LAS float* fs = (LAS float*)(lds + 72704);
    LAS float *liv = fs, *lfv = fs + 64, *av = fs + 128, *pmx = fs + 192, *rsp = fs + 256  , *knp = fs + 384  , *bcs = fs + 896  ;
    const int pr = tid >> 3, pp = tid & 7;
    LAS float* cvt = (LAS float*)(lds + 76544);
    for (int i = tid; i < 8 * 640; i += 512) { const int h_ = i / 640, r_ = i % 640; cvt[i] = (r_ < 512) ? convw[((r_ >> 6) & 3) * 1024 + (r_ >> 8) * 512 + h_ * 64 + (r_ & 63)] : convb[((r_ - 512) >> 6) * 512 + h_ * 64 + (r_ & 63)]; }
    __syncthreads();
    MpPf PA, PB;
    if (bid < 4096) { mp_load(PA, bid, tid, lane, QKR, OGT, VTT, LIb, LFb); mp_load(PB, (bid + G < 4096) ? bid + G : bid, tid, lane, QKR, OGT, VTT, LIb, LFb); }
#define MP_STEP(P, it) do { \
        const int b = it >> 9, h = (it >> 6) & 7, c = it & 63; const size_t m0 = (size_t)b * SEQ + (size_t)c * 64; \
        *(LAS u32x4*)(QR + (3 + pr) * 64 + 8 * pp) = P.pq; *(LAS u32x4*)(KR + (3 + pr) * 64 + 8 * pp) = P.pk; \
        if (tid < 24) { *(LAS u32x4*)(QR + pr * 64 + 8 * pp) = P.phq; *(LAS u32x4*)(KR + pr * 64 + 8 * pp) = P.phk; } \
        { const float pgv = ((h & 3) == 0) ? P.pg4[0] : ((h & 3) == 1) ? P.pg4[1] : ((h & 3) == 2) ? P.pg4[2] : P.pg4[3]; if (tid < 64) liv[tid] = pgv; else if (tid < 128) lfv[tid - 64] = pgv; } \
        float wq[4], wk4[4]; const float bq = cvt[h * 640 + 512 + lane], bk = cvt[h * 640 + 576 + lane]; \
        _Pragma("unroll") \
        for (int j = 0; j < 4; ++j) { wq[j] = cvt[h * 640 + j * 64 + lane]; wk4[j] = cvt[h * 640 + 256 + j * 64 + lane]; } \
        __syncthreads(); \
        { const int itn_ = (it + 2 * G < 4096) ? it + 2 * G : it; mp_load(P, itn_, tid, lane, QKR, OGT, VTT, LIb, LFb); } \
        if (w == 0) { \
            const float bsum = wave_scan_add(lfv[lane]); \
            const float a = liv[lane] - bsum; const float pm = wave_scan_max(a); \
            av[lane] = a; pmx[lane] = pm; bcs[lane] = bsum; \
        } \
        float kk8[8]; \
        { float xq[11], xk[11]; \
        _Pragma("unroll") \
          for (int r = 0; r < 11; ++r) { xq[r] = bf2f(QR[(8 * w + r) * 64 + lane]); xk[r] = bf2f(KR[(8 * w + r) * 64 + lane]); } \
        _Pragma("unroll") \
          for (int e = 0; e < 8; ++e) { float aq = bq, ak = bk; \
        _Pragma("unroll") \
              for (int j = 0; j < 4; ++j) { aq += wq[j] * xq[e + j]; ak += wk4[j] * xk[e + j]; } \
              aq = siluf_(aq); kk8[e] = siluf_(ak) * 0.125f; \
              Qc[(8 * w + e) * 72 + lane] = (bf16_t)f2bf(aq); Kc[(8 * w + e) * 72 + lane] = (bf16_t)f2bf(kk8[e]); } } \
        __syncthreads(); \
        { const float pm63 = pmx[63]; float ksum = 0.f; float kt[8]; \
        _Pragma("unroll") \
          for (int e = 0; e < 8; ++e) { kt[e] = kk8[e] * __expf(av[8 * w + e] - pm63); ksum += kt[e]; } \
          u32x4 o; o.x = pk2(kt[0], kt[1]); o.y = pk2(kt[2], kt[3]); o.z = pk2(kt[4], kt[5]); o.w = pk2(kt[6], kt[7]); \
          *(LAS u32x4*)(KT + lane * 72 + 8 * w) = o; knp[w * 64 + lane] = ksum; } \
        { const int ti = w >> 1; float psum = 0.f; \
        _Pragma("unroll") \
          for (int jj = 0; jj < 2; ++jj) { const int tj = 2 * (w & 1) + jj; const int t = 16 * ti + l15; \
              if (tj > ti) { *(LAS u32x2*)(Sm + t * 72 + 16 * tj + 4 * q4) = (u32x2){0u, 0u}; } \
              else { f32x4 acc = (f32x4){0.f, 0.f, 0.f, 0.f}; \
        _Pragma("unroll") \
                  for (int kk = 0; kk < 2; ++kk) { const bf16x8 a = *(const LAS bf16x8*)(Kc + (16 * tj + l15) * 72 + 32 * kk + 8 * q4), bq8 = *(const LAS bf16x8*)(Qc + (16 * ti + l15) * 72 + 32 * kk + 8 * q4); \
                      acc = MFMA16(a, bq8, acc); } \
                  const float pt = pmx[t]; const f32x4 a4 = *(const LAS f32x4*)(av + 16 * tj + 4 * q4); float vv[4]; float p = 0.f; \
        _Pragma("unroll") \
                  for (int r = 0; r < 4; ++r) { const int s = 16 * tj + 4 * q4 + r; vv[r] = (s <= t) ? acc[r] * __expf(a4[r] - pt) : 0.f; p += vv[r]; } \
                  u32x2 o; o.x = pk2(vv[0], vv[1]); o.y = pk2(vv[2], vv[3]); *(LAS u32x2*)(Sm + t * 72 + 16 * tj + 4 * q4) = o; \
                  psum += p; } } \
          psum += __shfl_xor(psum, 16); psum += __shfl_xor(psum, 32); \
          if (lane < 16) rsp[(w & 1) * 64 + 16 * ti + lane] = psum; } \
        __syncthreads(); \
        *(u32x4*)(U + (size_t)it * 4096 + tid * 8) = *(const LAS u32x4*)(Sm + pr * 72 + 8 * pp); \
        if (tid < 64) { SCT[(size_t)it * 64 + tid] = (f32x4){bcs[tid], pmx[tid], rsp[tid] + rsp[64 + tid], 0.f}; \
            const float kn = ((knp[tid] + knp[64 + tid]) + (knp[128 + tid] + knp[192 + tid])) + ((knp[256 + tid] + knp[320 + tid]) + (knp[384 + tid] + knp[448 + tid])); \
            SCI[(size_t)it * 64 + tid] = (f32x4){kn, pmx[63], bcs[63], 0.f}; } \
        *(u32x4*)(QKT + (size_t)it * 8192 + tid * 8) = *(const LAS u32x4*)(Qc + pr * 72 + 8 * pp); \
        *(u32x4*)(QKT + (size_t)it * 8192 + 4096 + tid * 8) = *(const LAS u32x4*)(KT + pr * 72 + 8 * pp); \
    } while (0)
    for (int it0 = bid; it0 < 4096; it0 += 2 * G) { MP_STEP(PA, it0); if (it0 + G < 4096) MP_STEP(PB, (it0 + G)); }
#undef MP_STEP
}

struct MsPf { u32x4 pq, pk, pv0, pv1, psm; u32x2 po; f32x4 pst, psi; };
__device__ __forceinline__ void ms_load(MsPf& P, int it_, int qd, int tid, int lane, int w, int l15, int q4, const bf16_t* OGT, const bf16_t* VTT, const f32x4* SCT, const f32x4* SCI, const bf16_t* QKT, const bf16_t* U) {
    const size_t ib = (size_t)it_ * 8192 + tid * 8;
    P.pq = *(const u32x4*)(QKT + (size_t)it_ * 8192 + (16 * qd) * 64 + (tid & 127) * 8);
    P.pk = *(const u32x4*)(QKT + ib + 4096); P.pv0 = *(const u32x4*)(VTT + ib); P.pv1 = *(const u32x4*)(VTT + ib + 4096);
    P.psm = *(const u32x4*)(U + (size_t)it_ * 4096 + (16 * qd) * 64 + (tid & 127) * 8);
    P.po = *(const u32x2*)(OGT + (size_t)it_ * 8192 + (16 * qd + l15) * 128 + 16 * w + 4 * q4);
    P.pst = SCT[(size_t)it_ * 64 + 16 * qd + l15]; P.psi = SCI[(size_t)it_ * 64 + lane];
}
__device__ __forceinline__ void mlstm_scan(LAS unsigned char* lds, int tid, int bid, int G, const bf16_t* OGT, const bf16_t* VTT, const f32x4* SCT, const f32x4* SCI,
                                           const bf16_t* QKT, const bf16_t* U, bf16_t* hh) {
    tid = opaque_v(tid); bid = opaque_s(bid);
    const int lane = tid & 63, w = __builtin_amdgcn_readfirstlane(tid >> 6), l15 = lane & 15, q4 = lane >> 4;
    LAS bf16_t* Qc = (LAS bf16_t*)(lds + 0);
    LAS bf16_t* KT = (LAS bf16_t*)(lds + 9216);
    LAS bf16_t* VT = (LAS bf16_t*)(lds + 18432);
    LAS bf16_t* CT = (LAS bf16_t*)(lds + 36864);
    LAS float* ssqp = (LAS float*)(lds + 57600);
    LAS bf16_t* Sq = (LAS bf16_t*)(lds + 58368);
    const int pr = tid >> 3, pp = tid & 7;
    for (int v = bid; v < 256; v += G) {
        const int qd = (v >> 3) & 3, unit = (v & 7) + 8 * (v >> 5);
        const int b = unit >> 3, h = unit & 7; const size_t mb = (size_t)b * SEQ; const int item0 = unit * 64;
        __syncthreads();
        for (int i = tid; i < 144 * 72 / 2; i += 512) ((LAS unsigned*)CT)[i] = 0u;
        f32x4 Cacc[4];
#pragma unroll
        for (int i = 0; i < 4; ++i) Cacc[i] = (f32x4){0.f, 0.f, 0.f, 0.f};
        float m_st = 0.f, nst = 0.f;
        MsPf PA, PB;
        ms_load(PA, item0, qd, tid, lane, w, l15, q4, OGT, VTT, SCT, SCI, QKT, U);
        ms_load(PB, item0 + 1, qd, tid, lane, w, l15, q4, OGT, VTT, SCT, SCI, QKT, U);
#define MS_STEP(P, cc) do { const size_t m0 = mb + (size_t)(cc) * 64 + 16 * qd; \
            if (tid < 128) { *(LAS u32x4*)(Qc + pr * 72 + 8 * pp) = P.pq; *(LAS u32x4*)(Sq + pr * 72 + 8 * pp) = P.psm; } \
            *(LAS u32x4*)(KT + pr * 72 + 8 * pp) = P.pk; *(LAS u32x4*)(VT + pr * 72 + 8 * pp) = P.pv0; *(LAS u32x4*)(VT + (64 + pr) * 72 + 8 * pp) = P.pv1; \
            const u32x2 og = P.po; const float bt = P.pst[0], pmt = P.pst[1], rst = P.pst[2], knv = P.psi[0], pm63 = P.psi[1], b63 = P.psi[2]; \
            __syncthreads(); \
            { const int cn = ((cc) + 2 < 64) ? (cc) + 2 : 63; ms_load(P, item0 + cn, qd, tid, lane, w, l15, q4, OGT, VTT, SCT, SCI, QKT, U); } \
            bf16x8 cf[2], cnf[2], vf[2], qf[2], smf[2], kf[4][2]; \
            _Pragma("unroll") for (int kk = 0; kk < 2; ++kk) { cf[kk] = *(const LAS bf16x8*)(CT + (16 * w + l15) * 72 + 32 * kk + 8 * q4); cnf[kk] = *(const LAS bf16x8*)(CT + (128 + l15) * 72 + 32 * kk + 8 * q4); \
                vf[kk] = *(const LAS bf16x8*)(VT + (16 * w + l15) * 72 + 32 * kk + 8 * q4); qf[kk] = *(const LAS bf16x8*)(Qc + l15 * 72 + 32 * kk + 8 * q4); smf[kk] = *(const LAS bf16x8*)(Sq + l15 * 72 + 32 * kk + 8 * q4); \
                _Pragma("unroll") for (int ti = 0; ti < 4; ++ti) kf[ti][kk] = *(const LAS bf16x8*)(KT + (16 * ti + l15) * 72 + 32 * kk + 8 * q4); } \
            f32x4 acc = (f32x4){0.f, 0.f, 0.f, 0.f}, accn = acc, u4 = acc, tmp[4]; \
            _Pragma("unroll") for (int kk = 0; kk < 2; ++kk) { acc = MFMA16(cf[kk], qf[kk], acc); accn = MFMA16(cnf[kk], qf[kk], accn); u4 = MFMA16(vf[kk], smf[kk], u4); } \
            _Pragma("unroll") for (int ti = 0; ti < 4; ++ti) { tmp[ti] = (f32x4){0.f, 0.f, 0.f, 0.f}; \
                _Pragma("unroll") for (int kk = 0; kk < 2; ++kk) tmp[ti] = MFMA16(kf[ti][kk], vf[kk], tmp[ti]); } \
            const float M63 = fmaxf(m_st, pm63), decay = __expf(m_st - M63), rho = __expf(pm63 - M63); \
            const float qn = accn[0]; \
            const float Mt = fmaxf(m_st, pmt), wt = __expf(m_st - Mt), rt = __expf(pmt - Mt); \
            const float den = wt * qn + rt * rst; const float dd = fmaxf(fabsf(den), __expf(-(bt + Mt))); \
            const f32x4 hv = (acc * wt + u4 * rt) * __builtin_amdgcn_rcpf(dd); \
            { const float p = rows4_sum((hv[0] * hv[0] + hv[1] * hv[1]) + (hv[2] * hv[2] + hv[3] * hv[3])); if (lane < 16) ssqp[lane * 8 + w] = p; } \
            _Pragma("unroll") for (int ti = 0; ti < 4; ++ti) Cacc[ti] = Cacc[ti] * decay + tmp[ti] * rho; \
            nst = nst * decay + knv * rho; \
            m_st = b63 + M63; \
            __syncthreads(); \
            _Pragma("unroll") for (int ti = 0; ti < 4; ++ti) { u32x2 o; o.x = pk2(Cacc[ti][0], Cacc[ti][1]); o.y = pk2(Cacc[ti][2], Cacc[ti][3]); *(LAS u32x2*)(CT + (16 * w + l15) * 72 + 16 * ti + 4 * q4) = o; } \
            if (w < 4) CT[(128 + 4 * w) * 72 + lane] = (bf16_t)f2bf(nst); \
            { const f32x4 s0 = *(const LAS f32x4*)(ssqp + l15 * 8), s1 = *(const LAS f32x4*)(ssqp + l15 * 8 + 4); \
              const float ssum = ((s0[0] + s0[1]) + (s0[2] + s0[3])) + ((s1[0] + s1[1]) + (s1[2] + s1[3])); \
              const float rstd = rsqrtf(ssum * (1.f / 128.f) + EPS); \
              u32x2 o; o.x = pk2(hv[0] * rstd * bf2f_lo(og.x), hv[1] * rstd * bf2f_hi(og.x)); o.y = pk2(hv[2] * rstd * bf2f_lo(og.y), hv[3] * rstd * bf2f_hi(og.y)); \
              *(u32x2*)(hh + (m0 + l15) * D + h * 128 + 16 * w + 4 * q4) = o; } \
        } while (0)
        for (int c = 0; c < 64; c += 2) { MS_STEP(PA, c); MS_STEP(PB, c + 1); }
#undef MS_STEP
    }
}

__device__ __forceinline__ int sw128(int r, int c) { return r * 136 + c; }
__device__ __forceinline__ int sw64(int r, int c) { return r * 72 + c; }
__device__ __forceinline__ void hgrn_prep(LAS unsigned char* lds, int tid, int bid, int G, bf16_t* QF, const bf16_t* VTT, bf16_t* OL, float* PFg) {
    tid = opaque_v(tid); bid = opaque_s(bid);
    const int lane = tid & 63, w = __builtin_amdgcn_readfirstlane(tid >> 6), l15 = lane & 15, q4 = lane >> 4;
    LAS bf16_t* QT = (LAS bf16_t*)(lds + 0);
    LAS bf16_t* KB = (LAS bf16_t*)(lds + 17408);
    LAS bf16_t* KH = (LAS bf16_t*)(lds + 34816);
    LAS bf16_t* QB = (LAS bf16_t*)(lds + 47872);
    LAS bf16_t* QH = (LAS bf16_t*)(lds + 65280);
    LAS bf16_t* KS = (LAS bf16_t*)(lds + 78336);
    LAS bf16_t* VT = (LAS bf16_t*)(lds + 96768);
    LAS bf16_t* AM = (LAS bf16_t*)(lds + 115200);
    LAS float* Fv = (LAS float*)(lds + 124416);
    const int d0 = 2 * (32 * (w & 1) + (lane & 31)), I = w >> 1, hf = lane >> 5, tb0 = 16 * I + 8 * hf;
    const int pr = tid >> 3, pp = tid & 7;
    unsigned pq2[8], pg2[8];
#define HP_PREFETCH(itx) do { const size_t qb_ = (size_t)(itx) * 16384 + (size_t)tb0 * 128 + d0; \
        _Pragma("unroll") for (int i = 0; i < 8; ++i) { pq2[i] = *(const unsigned*)(QF + qb_ + i * 128); pg2[i] = *(const unsigned*)(QF + qb_ + 8192 + i * 128); } \
        } while (0)
    if (bid < 4096) HP_PREFETCH(bid);
    for (int it = bid; it < 4096; it += G) {
        unsigned qtp[8], kbp[8];
        { float ca[8], cb[8], fa[8], fb[8]; float ea = 1.f, eb = 1.f;
#pragma unroll
          for (int i = 0; i < 8; ++i) { fa[i] = __expf(bf2f_lo(pg2[i])); fb[i] = __expf(bf2f_hi(pg2[i])); ea *= fa[i]; eb *= fb[i]; ca[i] = ea; cb[i] = eb; }
          const float ta = __shfl(ea, lane & 31), tb = __shfl(eb, lane & 31);
          const float pa = hf ? ta : 1.f, pb = hf ? tb : 1.f;
#pragma unroll
          for (int i = 0; i < 8; ++i) { const float e1a = ca[i] * pa, e1b = cb[i] * pb; const float ia = __builtin_amdgcn_rcpf(e1a), ib = __builtin_amdgcn_rcpf(e1b);
              qtp[i] = pk2(bf2f_lo(pq2[i]) * e1a, bf2f_hi(pq2[i]) * e1b); kbp[i] = pk2((1.f - fa[i]) * ia, (1.f - fb[i]) * ib);
              *(LAS unsigned*)(QT + sw128(tb0 + i, d0)) = qtp[i]; *(LAS unsigned*)(KB + sw128(tb0 + i, d0)) = kbp[i]; }
          if (hf) { Fv[I * 128 + d0] = ca[7] * pa; Fv[I * 128 + d0 + 1] = cb[7] * pb; } }
        __syncthreads();
        { const int itn_ = (it + G < 4096) ? it + G : it; HP_PREFETCH(itn_); }
        { const f32x2 F0 = *(const LAS f32x2*)(Fv + d0), F1 = *(const LAS f32x2*)(Fv + 128 + d0), F2 = *(const LAS f32x2*)(Fv + 256 + d0), F3 = *(const LAS f32x2*)(Fv + 384 + d0);
          const f32x2 one = (f32x2){1.f, 1.f};
          const f32x2 FI = (I == 0) ? F0 : (I == 1) ? F1 : (I == 2) ? F2 : F3;
          const f32x2 P = (I == 0) ? one : (I == 1) ? F0 : (I == 2) ? F0 * F1 : F0 * F1 * F2;
          const f32x2 suf = (I == 0) ? F1 * F2 * F3 : (I == 1) ? F2 * F3 : (I == 2) ? F3 : one;
          float ksa[8], ksb[8];
#pragma unroll
          for (int i = 0; i < 8; ++i) { const int t = tb0 + i; const float qa = bf2f_lo(qtp[i]), qb = bf2f_hi(qtp[i]); const float ka = bf2f_lo(kbp[i]) * FI.x, kb = bf2f_hi(kbp[i]) * FI.y;
              if (I < 3) *(LAS unsigned*)(KH + sw128(t, d0)) = pk2(ka, kb);
              *(LAS unsigned*)(QB + sw128(t, d0)) = pk2(qa * P.x, qb * P.y);
              ksa[i] = ka * suf.x; ksb[i] = kb * suf.y;
              if (I == 2) *(LAS unsigned*)(QH + sw128(8 * hf + i, d0)) = pk2(qa * F1.x, qb * F1.y);
              if (I == 3) { *(LAS unsigned*)(QH + sw128(16 + 8 * hf + i, d0)) = pk2(qa * F2.x, qb * F2.y);
                  *(LAS unsigned*)(QH + sw128(32 + 8 * hf + i, d0)) = pk2(qa * (F1.x * F2.x), qb * (F1.y * F2.y)); } }
          u32x4 oa, ob; oa.x = pk2(ksa[0], ksa[1]); oa.y = pk2(ksa[2], ksa[3]); oa.z = pk2(ksa[4], ksa[5]); oa.w = pk2(ksa[6], ksa[7]);
          ob.x = pk2(ksb[0], ksb[1]); ob.y = pk2(ksb[2], ksb[3]); ob.z = pk2(ksb[4], ksb[5]); ob.w = pk2(ksb[6], ksb[7]);
          *(LAS u32x4*)(KS + sw64(d0, tb0)) = oa; *(LAS u32x4*)(KS + sw64(d0 + 1, tb0)) = ob;
          if (I == 0 && hf == 0) { PFg[(size_t)it * 128 + d0] = (F0.x * F1.x) * (F2.x * F3.x); PFg[(size_t)it * 128 + d0 + 1] = (F0.y * F1.y) * (F2.y * F3.y); } }
        __syncthreads();
#pragma unroll
        for (int jj = 0; jj < 2; ++jj) { const int blk = 2 * w + jj, bi = blk >> 2, bj = blk & 3; const int t = 16 * bi + l15;
            if (bj > bi) { *(LAS u32x2*)(AM + sw64(t, 16 * bj + 4 * q4)) = (u32x2){0u, 0u}; }
            else { const LAS bf16_t* X; int xr; const LAS bf16_t* Yk = (bi == bj) ? KB : KH;
                if (bj + 1 >= bi) { X = QT; xr = 16 * bi; } else { X = QH; xr = (bi == 2) ? 0 : (bj == 1 ? 16 : 32); }
                f32x4 acc = (f32x4){0.f, 0.f, 0.f, 0.f};
#pragma unroll
                for (int kk = 0; kk < 4; ++kk) { const bf16x8 a = *(const LAS bf16x8*)(Yk + sw128(16 * bj + l15, 32 * kk + 8 * q4)), bq8 = *(const LAS bf16x8*)(X + sw128(xr + l15, 32 * kk + 8 * q4)); acc = MFMA16(a, bq8, acc); }
                float vv[4];
#pragma unroll
                for (int r = 0; r < 4; ++r) { const int s = 16 * bj + 4 * q4 + r; vv[r] = (s <= t) ? acc[r] : 0.f; }
                u32x2 o; o.x = pk2(vv[0], vv[1]); o.y = pk2(vv[2], vv[3]); *(LAS u32x2*)(AM + sw64(t, 16 * bj + 4 * q4)) = o; } }
        __syncthreads();
        *(u32x4*)(OL + (size_t)it * 4096 + tid * 8) = *(const LAS u32x4*)(AM + sw64(pr, 8 * pp));
#pragma unroll
        for (int j = 0; j < 2; ++j) { const int p = tid + 512 * j;
            *(u32x4*)(QF + (size_t)it * 16384 + p * 8) = *(const LAS u32x4*)(QB + sw128(p >> 4, 8 * (p & 15)));
            *(u32x4*)(QF + (size_t)it * 16384 + 8192 + p * 8) = *(const LAS u32x4*)(KS + sw64(p >> 3, 8 * (p & 7))); }
    }
#undef HP_PREFETCH
}

struct HsPf { u32x4 pqb, pks[2], pv0, pv1, pam; u32x2 pgt; f32x4 ppf; };
__device__ __forceinline__ void hs_load(HsPf& P, int it_, int qd, int tid, int lane, int w, int l15, int q4, const bf16_t* QF, const bf16_t* GT, const bf16_t* VTT, const bf16_t* OL, const float* PFg) {
    P.pqb = *(const u32x4*)(QF + (size_t)it_ * 16384 + (16 * qd) * 128 + (tid & 255) * 8);
#pragma unroll
    for (int j = 0; j < 2; ++j) P.pks[j] = *(const u32x4*)(QF + (size_t)it_ * 16384 + 8192 + (tid + 512 * j) * 8);
    P.pv0 = *(const u32x4*)(VTT + (size_t)it_ * 8192 + tid * 8); P.pv1 = *(const u32x4*)(VTT + (size_t)it_ * 8192 + 4096 + tid * 8);
    P.pam = *(const u32x4*)(OL + (size_t)it_ * 4096 + (16 * qd) * 64 + (tid & 127) * 8);
    P.pgt = *(const u32x2*)(GT + (size_t)it_ * 8192 + (16 * qd + l15) * 128 + 16 * w + 4 * q4);
    P.ppf = *(const f32x4*)(PFg + (size_t)it_ * 128 + 4 * (tid & 31));
}
__device__ __forceinline__ void hgrn_scan(LAS unsigned char* lds, int tid, int bid, int G, const bf16_t* QF, const bf16_t* GT, const bf16_t* VTT, const bf16_t* OL, const float* PFg, const float* normw, bf16_t* hh) {
    tid = opaque_v(tid); bid = opaque_s(bid);
    const int lane = tid & 63, w = __builtin_amdgcn_readfirstlane(tid >> 6), l15 = lane & 15, q4 = lane >> 4;
    LAS bf16_t* QB = (LAS bf16_t*)(lds + 0);
    LAS bf16_t* KS = (LAS bf16_t*)(lds + 17408);
    LAS bf16_t* VT = (LAS bf16_t*)(lds + 35840);
    LAS bf16_t* ST = (LAS bf16_t*)(lds + 54272);
    LAS float* PF = (LAS float*)(lds + 89088);
    LAS float* ssqp = (LAS float*)(lds + 89600);
    LAS float* nw = (LAS float*)(lds + 91648);
    LAS bf16_t* Aq = (LAS bf16_t*)(lds + 92160);
    const int pr = tid >> 3, pp = tid & 7;
    for (int v = bid; v < 256; v += G) {
        const int qd = (v >> 3) & 3, unit = (v & 7) + 8 * (v >> 5);
        const int b = unit >> 3, h = unit & 7; const size_t mb = (size_t)b * SEQ; const int item0 = unit * 64;
        __syncthreads();
        if (tid < 128) nw[tid] = normw[h * 128 + tid];
        for (int i = tid; i < 128 * 136 / 2; i += 512) ((LAS unsigned*)ST)[i] = 0u;
        f32x4 Sacc[8];
#pragma unroll
        for (int i = 0; i < 8; ++i) Sacc[i] = (f32x4){0.f, 0.f, 0.f, 0.f};
        HsPf PA, PB;
        hs_load(PA, item0, qd, tid, lane, w, l15, q4, QF, GT, VTT, OL, PFg); hs_load(PB, item0 + 1, qd, tid, lane, w, l15, q4, QF, GT, VTT, OL, PFg);
#define HS_STEP(P, cc) do { const size_t m0 = mb + (size_t)(cc) * 64 + 16 * qd; \
            if (tid < 256) *(LAS u32x4*)(QB + sw128(tid >> 4, 8 * (tid & 15))) = P.pqb; \
            _Pragma("unroll") for (int j = 0; j < 2; ++j) { const int p = tid + 512 * j; *(LAS u32x4*)(KS + sw64(p >> 3, 8 * (p & 7))) = P.pks[j]; } \
            *(LAS u32x4*)(VT + pr * 72 + 8 * pp) = P.pv0; *(LAS u32x4*)(VT + (64 + pr) * 72 + 8 * pp) = P.pv1; \
            if (tid < 32) *(LAS f32x4*)(PF + 4 * tid) = P.ppf; \
            if (tid < 128) *(LAS u32x4*)(Aq + pr * 72 + 8 * pp) = P.pam; \
            const u32x2 gg = P.pgt; \
            __syncthreads(); \
            { const int cn = ((cc) + 2 < 64) ? (cc) + 2 : 63; hs_load(P, item0 + cn, qd, tid, lane, w, l15, q4, QF, GT, VTT, OL, PFg); } \
            f32x4 ov = (f32x4){0.f, 0.f, 0.f, 0.f}; \
            bf16x8 vf[2]; \
            _Pragma("unroll") for (int kk = 0; kk < 2; ++kk) vf[kk] = *(const LAS bf16x8*)(VT + sw64(16 * w + l15, 32 * kk + 8 * q4)); \
            { bf16x8 sf[4], qf[4], af[2]; \
              _Pragma("unroll") for (int kk = 0; kk < 4; ++kk) { sf[kk] = *(const LAS bf16x8*)(ST + sw128(16 * w + l15, 32 * kk + 8 * q4)); qf[kk] = *(const LAS bf16x8*)(QB + sw128(l15, 32 * kk + 8 * q4)); } \
              _Pragma("unroll") for (int kk = 0; kk < 2; ++kk) af[kk] = *(const LAS bf16x8*)(Aq + l15 * 72 + 32 * kk + 8 * q4); \
              _Pragma("unroll") for (int kk = 0; kk < 2; ++kk) ov = MFMA16(vf[kk], af[kk], ov); \
              _Pragma("unroll") for (int kk = 0; kk < 4; ++kk) ov = MFMA16(sf[kk], qf[kk], ov); } \
            { \
              _Pragma("unroll") for (int dh = 0; dh < 2; ++dh) { bf16x8 kf[4][2]; \
                  _Pragma("unroll") for (int kk = 0; kk < 2; ++kk) _Pragma("unroll") for (int dq = 0; dq < 4; ++dq) kf[dq][kk] = *(const LAS bf16x8*)(KS + sw64(16 * (4 * dh + dq) + l15, 32 * kk + 8 * q4)); \
                  _Pragma("unroll") for (int dq = 0; dq < 4; ++dq) { const int di = 4 * dh + dq; const f32x4 pf = *(const LAS f32x4*)(PF + 16 * di + 4 * q4); Sacc[di] = Sacc[di] * pf; \
                      _Pragma("unroll") for (int kk = 0; kk < 2; ++kk) Sacc[di] = MFMA16(kf[dq][kk], vf[kk], Sacc[di]); } } } \
            { const float p = rows4_sum((ov[0] * ov[0] + ov[1] * ov[1]) + (ov[2] * ov[2] + ov[3] * ov[3])); if (lane < 16) ssqp[lane * 8 + w] = p; } \
            __syncthreads(); \
            _Pragma("unroll") for (int di = 0; di < 8; ++di) { u32x2 o; o.x = pk2_acc(Sacc[di][0], Sacc[di][1]); o.y = pk2_acc(Sacc[di][2], Sacc[di][3]); *(LAS u32x2*)(ST + sw128(16 * w + l15, 16 * di + 4 * q4)) = o; } \
            { const f32x4 nw4 = *(const LAS f32x4*)(nw + 16 * w + 4 * q4); \
              const f32x4 s0 = *(const LAS f32x4*)(ssqp + l15 * 8), s1 = *(const LAS f32x4*)(ssqp + l15 * 8 + 4); \
              const float ssum = ((s0[0] + s0[1]) + (s0[2] + s0[3])) + ((s1[0] + s1[1]) + (s1[2] + s1[3])); \
              const float rstd = rsqrtf(ssum * (1.f / 128.f) + EPS); \
              const float g0 = bf2f_lo(gg.x), g1 = bf2f_hi(gg.x), g2 = bf2f_lo(gg.y), g3 = bf2f_hi(gg.y); \
              u32x2 o; o.x = pk2(ov[0] * rstd * nw4[0] * g0, ov[1] * rstd * nw4[1] * g1); o.y = pk2(ov[2] * rstd * nw4[2] * g2, ov[3] * rstd * nw4[3] * g3); \
              *(u32x2*)(hh + (m0 + l15) * D + h * 128 + 16 * w + 4 * q4) = o; } \
        } while (0)
        for (int c = 0; c < 64; c += 2) { HS_STEP(PA, c); HS_STEP(PB, c + 1); }
#undef HS_STEP
    }
}

constexpr int N_PHASES = 34;
#ifndef MK_KIND_MASK
#define MK_KIND_MASK 0x3FFFF
#endif
#define KIND(k) ((MK_KIND_MASK >> (k)) & 1)
#ifndef MK_TWICE_MASK
#define MK_TWICE_MASK 0
#endif
#define TWICE(k, body) do { body; if ((MK_TWICE_MASK >> (k)) & 1) { xcd_barrier(bar); body; } } while (0)
#ifndef MK_CUT
#define MK_CUT 32
#endif
#define tid (wave_s * 64 + lane_id())
#define IN(k) (lo <= (k) && (k) < hi)
#define SEAM(k) do { if (IN(k) && IN((k) + 1)) { if (MK_N_LAUNCHES == 1) xcd_barrier(bar); else if (tid == 0) __hip_atomic_store(ctl + CW_TMO, 0xBAD0u, __ATOMIC_RELAXED, __HIP_MEMORY_SCOPE_AGENT); } } while (0)
#define ws (kws())
#define ctl ((unsigned*)(ws + WS_CTL))
#define mod ((float*)(ws + WS_MOD))
#define xo ((bf16_t*)kout())
#define R1 ((bf16_t*)(ws + WS_R1))
#define HN ((bf16_t*)(ws + WS_R2))
#define YB ((bf16_t*)(ws + WS_R2))
#define LI ((float*)(ws + WS_LI))
#define LF ((float*)(ws + WS_LF))
#define LTOK ((int*)(ws + WS_LTOK))
#define LW ((float*)(ws + WS_LW))


template <int LP>
__device__ __forceinline__ void layer_pair(LAS unsigned char* lds, const int wave_s, const int bid, const int G, const int lo, const int hi, const XcdBarrier& bar) {
        constexpr int lp = LP;
        const int pb = 1 + 16 * lp;
        unsigned char* wb = ws + WS_WGT + (size_t)lp * LP_BYTES;
        unsigned* gcnt = ctl + CW_CNT + 64 * lp;
        { const int L = 2 * lp; const float* modL = mod + (size_t)L * 8 * 6144;
          const bf16_t* hnA = (lp == 0) ? HN : (const bf16_t*)(ws + WS_R1);
          bf16_t* QKR = (bf16_t*)(ws + WS_R1 + (lp == 0 ? 0 : 64) * MiB);
          bf16_t* OGT = (bf16_t*)(ws + WS_R1 + (lp == 0 ? 64 : 128) * MiB);
          bf16_t* VTm = (bf16_t*)(ws + WS_R1 + (lp == 0 ? 128 : 192) * MiB);
          bf16_t* QKT = (bf16_t*)(ws + WS_R1 + (lp == 0 ? 192 : 0) * MiB);
          bf16_t* UU = (bf16_t*)(ws + WS_R2U);
          if (KIND(1) && IN(pb + 0)) {
              if (lp == 0) TWICE(1, (norm_phase<1, false, true>(lds, tid, bid, G, karg(I_X), xo, YB, karg(I_N1W) + L * 1024, modL + 0, modL + 1024, HN, (const float*)(wb + W_MGATE), karg(I_MIB) + lp * 8, karg(I_MFB) + lp * 8, LI, LF, nullptr, nullptr, nullptr)));
              else norm_phase<1, true>(lds, tid, bid, G, xo, xo, YB, karg(I_N1W) + L * 1024, modL + 0, modL + 1024, (bf16_t*)(ws + WS_R1), (const float*)(wb + W_MGATE), karg(I_MIB) + lp * 8, karg(I_MFB) + lp * 8, LI, LF, nullptr, nullptr, nullptr);
          }
          SEAM(pb + 0);
          if (KIND(2) && IN(pb + 1)) {
              { pg8::Gemm g{hnA, (const bf16_t*)(wb + W_MIN), T, 2048, D, 0}; pg8::StaticOrder S; S.init(T, 2048, G, bid);
                pg8::EpiTile<0> E{QKR, OGT, karg(I_MNW) + lp * 1024};
                TWICE(2, (pg8::gemm_phase<pg8::EpiTile<0>, pg8::StaticOrder, true, false>(lds, g, S, E, wave_s))); }
              { pg8::Gemm g{(const bf16_t*)(wb + W_MIN) + (size_t)2048 * 1024, hnA, 1024, T, D, 0}; pg8::StaticOrder S; S.init(1024, T, G, bid);
                pg8::EpiVT E{VTm};
                TWICE(2, (pg8::gemm_phase<pg8::EpiVT, pg8::StaticOrder, true, false>(lds, g, S, E, wave_s))); }
          }
          SEAM(pb + 1);
          if (KIND(16) && IN(pb + 2)) TWICE(16, mlstm_prep(lds, tid, bid, G, QKR, OGT, VTm, LI, LF, (f32x4*)(ws + WS_SCT), (f32x4*)(ws + WS_SCI), karg(I_MCW) + (size_t)lp * 4 * 1024, karg(I_MCB) + lp * 1024, karg(I_MNW) + lp * 1024, QKT, UU));
          SEAM(pb + 2);
          if (KIND(3) && IN(pb + 3)) { TWICE(3, mlstm_scan(lds, tid, bid, G, OGT, VTm, (const f32x4*)(ws + WS_SCT), (const f32x4*)(ws + WS_SCI), QKT, UU, HN));
 }
          SEAM(pb + 3);
          if (KIND(4) && IN(pb + 4)) {
              pg8::Gemm g{HN, (const bf16_t*)(wb + W_MOUT), T, D, D, 0}; pg8::StaticOrder S; S.init(T, D, G, bid);
              if (lp == 0) { pg8::EpiResid<true> E{karg(I_X), xo, modL + 2048}; pg8::gemm_phase<pg8::EpiResid<true>, pg8::StaticOrder, true, false>(lds, g, S, E, wave_s); }
              else { pg8::EpiResid<false> E{xo, xo, modL + 2048}; pg8::gemm_phase<pg8::EpiResid<false>, pg8::StaticOrder, true, false>(lds, g, S, E, wave_s); }
          }
          SEAM(pb + 4);
          if (KIND(5) && IN(pb + 5)) TWICE(5, (norm_phase<0, false>(lds, tid, bid, G, xo, xo, YB, karg(I_N2W) + L * 1024, modL + 3072, modL + 4096, HN, nullptr, nullptr, nullptr, nullptr, nullptr, nullptr, nullptr, nullptr)));
          SEAM(pb + 5);
          if (KIND(6) && IN(pb + 6)) {
              pg8::Gemm g{HN, (const bf16_t*)(wb + W_FGU), T, 2 * DFF, D, 0}; pg8::StaticOrder S; S.init(T, 2 * DFF, G, bid);
              pg8::EpiSwiGLU E{R1, DFF};
              TWICE(6, (pg8::gemm_phase<pg8::EpiSwiGLU, pg8::StaticOrder, true, false>(lds, g, S, E, wave_s)));
          }
          SEAM(pb + 6);
          if (KIND(7) && IN(pb + 7)) {
              pg8::Gemm g{R1, (const bf16_t*)(wb + W_FD), T, D, DFF, 0}; pg8::StaticOrder S; S.init(T, D, G, bid);
              pg8::EpiResid<false> E{xo, xo, modL + 5120};
              pg8::gemm_phase<pg8::EpiResid<false>, pg8::StaticOrder, true, false>(lds, g, S, E, wave_s);
          }
          SEAM(pb + 7);
        }
        { const int L = 2 * lp + 1; const float* modL = mod + (size_t)L * 8 * 6144;
          bf16_t* QF = R1;
          bf16_t* GT = (bf16_t*)(ws + WS_R1 + 128 * MiB);
          bf16_t* VTh = (bf16_t*)(ws + WS_R1 + 192 * MiB);
          bf16_t* OL = (bf16_t*)(ws + WS_R2U);
          float* PFg = (float*)(ws + WS_RS);
          if (KIND(8) && IN(pb + 8)) norm_phase<0, false>(lds, tid, bid, G, xo, xo, YB, karg(I_N1W) + L * 1024, modL + 0, modL + 1024, HN, nullptr, nullptr, nullptr, nullptr, nullptr, nullptr, nullptr, nullptr);
          SEAM(pb + 8);
          if (KIND(9) && IN(pb + 9)) {
              { pg8::Gemm g{HN, (const bf16_t*)(wb + W_HIN), T, 3072, D, 0}; pg8::StaticOrder S; S.init(T, 3072, G, bid);
                pg8::EpiTile<1> E{QF, GT, (lp == 0) ? nullptr : (const float*)(ws + WS_LB)};
                TWICE(9, (pg8::gemm_phase<pg8::EpiTile<1>, pg8::StaticOrder, true, false>(lds, g, S, E, wave_s))); }
              { pg8::Gemm g{(const bf16_t*)(wb + W_HIN) + (size_t)3072 * 1024, HN, 1024, T, D, 0}; pg8::StaticOrder S; S.init(1024, T, G, bid);
                pg8::EpiVT E{VTh};
                TWICE(9, (pg8::gemm_phase<pg8::EpiVT, pg8::StaticOrder, true, false>(lds, g, S, E, wave_s))); }
          }
          SEAM(pb + 9);
          if (KIND(17) && IN(pb + 10)) TWICE(17, hgrn_prep(lds, tid, bid, G, QF, VTh, OL, PFg));
          SEAM(pb + 10);
          if (KIND(10) && IN(pb + 11)) TWICE(10, hgrn_scan(lds, tid, bid, G, QF, GT, VTh, OL, PFg, karg(I_HNW) + lp * 1024, HN));
          SEAM(pb + 11);
          if (KIND(11) && IN(pb + 12)) {
              pg8::Gemm g{HN, (const bf16_t*)(wb + W_HOUT), T, D, D, 0}; pg8::StaticOrder S; S.init(T, D, G, bid);
              pg8::EpiResid<false> E{xo, xo, modL + 2048};
              pg8::gemm_phase<pg8::EpiResid<false>, pg8::StaticOrder, true, false>(lds, g, S, E, wave_s);
          }
          SEAM(pb + 12);
          if (KIND(12) && IN(pb + 13)) norm_phase<2, false>(lds, tid, bid, G, xo, xo, YB, karg(I_N2W) + L * 1024, modL + 3072, modL + 4096, HN, (const float*)(wb + W_ROUT), nullptr, nullptr, nullptr, nullptr, gcnt, LTOK, LW);
          SEAM(pb + 13);
          if (KIND(13) && IN(pb + 14)) {
              pg8::Gemm g{HN, (const bf16_t*)(wb + W_EGU), T, 2 * DFE, D, (size_t)2 * DFE * D}; pg8::MoeOrder S; S.init(gcnt, LTOK, (2 * DFE) / 256, G, bid, (LAS int*)(lds + MISC_OFF + 64), wave_s);
              pg8::EpiSwiGLU E{R1, DFE};
              TWICE(13, (pg8::gemm_phase<pg8::EpiSwiGLU, pg8::MoeOrder, true, true>(lds, g, S, E, wave_s)));
              if (lp == 0) tail_convert(lds, tid, bid, G, S.nwg, CV_PER_LP, CV_PER_LP + CV_TAIL1);
          }
          SEAM(pb + 14);
          if (KIND(14) && IN(pb + 15)) {
              pg8::Gemm g{R1, (const bf16_t*)(wb + W_ED), T, D, DFE, (size_t)D * DFE}; pg8::MoeOrder S; S.init(gcnt, LTOK, D / 256, G, bid, (LAS int*)(lds + MISC_OFF + 64), wave_s);
              pg8::EpiMoeDown E{YB, LTOK, LW, gcnt, modL + 5120};
              TWICE(14, (pg8::gemm_phase<pg8::EpiMoeDown, pg8::MoeOrder, true, false>(lds, g, S, E, wave_s)));
              if (lp == 0) tail_convert(lds, tid, bid, G, S.nwg, CV_PER_LP + CV_TAIL1, 2 * CV_PER_LP);
          }
          SEAM(pb + 15);
        }
}

__global__ void __launch_bounds__(512, 2) mk_fwd(Args args) {
    extern __shared__ __attribute__((aligned(16))) unsigned char lds_raw[];
    LAS unsigned char* lds = (LAS unsigned char*)lds_raw;
    const int wave_s = __builtin_amdgcn_readfirstlane((int)threadIdx.x >> 6);
    const int bid = blockIdx.x, G = gridDim.x;
    volatile LAS unsigned* MISC = (volatile LAS unsigned*)(lds + MISC_OFF);
    if (tid < 64) MISC[tid] = 0u;
    __syncthreads();
    XcdBarrier bar; bar.bar = (unsigned*)(kws() + WS_CTL) + CW_BAR; bar.x = 0; bar.st = nullptr; bar.wv = wave_s;
    if (MK_N_LAUNCHES == 1) bar = xcd_barrier_post((unsigned*)(kws() + WS_CTL) + CW_BAR, MISC, wave_s);
    const int lo = __builtin_amdgcn_readfirstlane(args.ph_lo), hi = __builtin_amdgcn_readfirstlane(args.ph_hi);
    if (KIND(0) && IN(0)) { TWICE(0, p0_phase(lds, tid, bid, G)); }
    SEAM(0);
    layer_pair<0>(lds, wave_s, bid, G, lo, hi, bar);
    layer_pair<1>(lds, wave_s, bid, G, lo, hi, bar);
    if (KIND(15) && IN(33)) { if (MK_CUT >= 32 || MK_CUT == 16) final_phase<true>(tid, bid, G, kout(), YB, karg(I_FNW)); else final_phase<false>(tid, bid, G, kout(), YB, karg(I_FNW)); }
#undef IN
#undef SEAM
#undef tid
#undef ws
#undef ctl
#undef mod
#undef xo
#undef R1
#undef HN
#undef YB
#undef LI
#undef LF
#undef LTOK
#undef LW
}

extern "C" void kernel_launch(void* const* d_in, const int* in_sizes, int n_in, void* d_out, int out_size, void* d_ws, size_t ws_size, hipStream_t stream) {
    static int grid = 0;
    if (grid == 0) {
        if (n_in != 25 || in_sizes[0] != T * D || out_size != T * D || ws_size < WS_END2) {
            fprintf(stderr, "kernel_launch: unexpected shapes (n_in %d, in0 %d, out %d, ws %zu < %zu)\n", n_in, n_in > 0 ? in_sizes[0] : -1, out_size, ws_size, (size_t)WS_END2); grid = -1; }
        else {
            int dev = 0, cus = 0;
            if (hipGetDevice(&dev) != hipSuccess || hipDeviceGetAttribute(&cus, hipDeviceAttributeMultiprocessorCount, dev) != hipSuccess) { grid = -1; }
            else if (hipFuncSetAttribute((const void*)mk_fwd, hipFuncAttributeMaxDynamicSharedMemorySize, LDS_BYTES) != hipSuccess) { fprintf(stderr, "kernel_launch: hipFuncSetAttribute failed\n"); grid = -1; }
            else { int per_cu = 0; (void)hipOccupancyMaxActiveBlocksPerMultiprocessor(&per_cu, (const void*)mk_fwd, 512, LDS_BYTES); (void)hipGetLastError();
                if (per_cu < 1) fprintf(stderr, "kernel_launch: occupancy query reports %d blocks per CU\n", per_cu);
                grid = cus; }
        }
    }
    if (grid < 0) { (void)hipMemsetAsync(d_out, 0xFF, (size_t)out_size * 4, stream); return; }
    (void)hipMemsetAsync((char*)d_ws + WS_CTL, 0, CTL_ZERO_BYTES, stream);
    Args a{};
    for (int i = 0; i < 25; ++i) a.in[i] = (const float*)d_in[i];
    a.out = (float*)d_out; a.ws = (unsigned char*)d_ws;
    if (MK_N_LAUNCHES == 1) { a.ph_lo = 0; a.ph_hi = N_PHASES; hipLaunchKernelGGL(mk_fwd, dim3(grid), dim3(512), LDS_BYTES, stream, a); }
    else { for (int p = 0; p < N_PHASES; ++p) { if (p > MK_CUT && p != N_PHASES - 1) continue; a.ph_lo = p; a.ph_hi = p + 1; hipLaunchKernelGGL(mk_fwd, dim3(grid), dim3(512), LDS_BYTES, stream, a); } }
}
```
